# Optimizing an MI355X kernel written in HIP

```python
import math
import jax
import jax.numpy as jnp
from jax import lax
import numpy as np

D_MODEL = 1024
BATCH = 4
SEQ = 4096
DEPTH = 4

F32 = jnp.float32
GRID_W = 64
CTX_LEN = 256
N_MIXERS = 3
N_LAYERS_RWKV = (DEPTH + 2) // 3
N_LAYERS_NA = (DEPTH + 1) // 3
N_LAYERS_S5 = DEPTH // 3
D_INNER = D_MODEL
NORM_EPS = 1e-6

RWKV_HEAD_DIM = 64
RWKV_HEADS = D_INNER // RWKV_HEAD_DIM
RWKV_DECAY_LORA = 64
RWKV_ICLR_LORA = 64
RWKV_GN_EPS = 64e-5
RWKV_N_MIX = 6

NA_HEAD_DIM = 64
NA_HEADS = D_INNER // NA_HEAD_DIM
NA_KH_MAX = 8
NA_KW = 16

S5_GROUP = 16
S5_GROUPS = D_INNER // S5_GROUP
S5_STATE = 64
S5_DT_MIN = 1e-3
S5_DT_MAX = 1e-1

kernel_name = "hybrid_rwkv7_natten_s5_prefix_block"


def _rms_norm(x, g):
    xf = x.astype(F32)
    y = xf * lax.rsqrt(jnp.mean(xf * xf, axis=-1, keepdims=True) + NORM_EPS)
    return (y * g.astype(F32)).astype(x.dtype)


def _head_rms(x, g):
    xf = x.astype(F32)
    y = xf * lax.rsqrt(jnp.mean(xf * xf, axis=-1, keepdims=True) + NORM_EPS)
    return (y * g.astype(F32)).astype(x.dtype)


def _head_l2norm(x, n_heads):
    xf = x.astype(F32).reshape(x.shape[:-1] + (n_heads, -1))
    n = jnp.sqrt(jnp.sum(xf * xf, axis=-1, keepdims=True))
    return (xf / jnp.maximum(n, 1e-12)).reshape(x.shape)


def _centred_shift(h):
    prev = jnp.pad(h[:, :-1], ((0, 0), (1, 0), (0, 0)))
    nxt = jnp.pad(h[:, 1:], ((0, 0), (0, 1), (0, 0)))
    return 0.5 * (prev + nxt)


def _seg_flip(a, n_ctx, axis):
    a_c, a_l = jnp.split(a, [n_ctx], axis=axis)
    return jnp.concatenate([jnp.flip(a_c, axis), jnp.flip(a_l, axis)], axis=axis)


def _rwkv7_step(state, inp):
    r, w, k, v, kk, a = inp
    sa = jnp.einsum("dbhvk,dbhk->dbhv", state, kk)
    state = (state * w[..., None, :] - sa[..., None] * (kk * a)[..., None, :]
             + v[..., None] * k[..., None, :])
    return state, jnp.einsum("dbhvk,dbhk->dbhv", state, r)


def _complex_affine_combine(e1, e2):
    a1r, a1i, b1r, b1i = e1
    a2r, a2i, b2r, b2i = e2
    return (a2r * a1r - a2i * a1i,
            a2r * a1i + a2i * a1r,
            a2r * b1r - a2i * b1i + b2r,
            a2r * b1i + a2i * b1r + b2i)


def _rwkv7_mixer(hc, hx, mu, w_rkvg, w0, w1, w2, a0, a1, a2, k_k, k_a, r_k,
                 ln_w, ln_b, w_out, need_ctx):
    dt = hx.dtype
    n_ctx = hc.shape[1]
    h = jnp.concatenate([hc, hx], axis=1)
    bsz, t_all, _ = h.shape
    xx = jnp.concatenate([_centred_shift(hc), _centred_shift(hx)], axis=1) - h
    xs = h[None] + xx[None] * mu[:, None, None, :]
    r, k, v, g = jnp.einsum("nbtd,nde->nbte", xs[:4], w_rkvg)
    dec_lora = jnp.einsum("sbtr,sre->sbte",
                          jnp.tanh(jnp.einsum("btd,sdr->sbtr", xs[4], w1)), w2)
    w_log = -jax.nn.softplus(-(w0[:, None, None, :] + dec_lora).astype(F32)) - 0.5
    decay = jnp.exp(-jnp.exp(w_log))
    iclr = jax.nn.sigmoid((a0[:, None, None, :] + jnp.einsum(
        "sbtr,sre->sbte", jnp.einsum("btd,sdr->sbtr", xs[5], a1), a2)).astype(F32))
    kk = _head_l2norm(k * k_k, RWKV_HEADS)
    k_dir = k.astype(F32)[None] * (1.0 + (iclr - 1.0) * k_a.astype(F32))

    def to_scan(a):
        a = jnp.stack([a[0], _seg_flip(a[1], n_ctx, 1)]).astype(F32)
        return a.reshape(2, bsz, t_all, RWKV_HEADS, RWKV_HEAD_DIM).transpose(2, 0, 1, 3, 4)

    def shared(a):
        return to_scan(jnp.stack([a, a]))

    s0 = jnp.zeros((2, bsz, RWKV_HEADS, RWKV_HEAD_DIM, RWKV_HEAD_DIM), F32)
    _, y = lax.scan(_rwkv7_step, s0, (shared(r), to_scan(decay), to_scan(k_dir),
                                      shared(v), shared(kk), to_scan(iclr)))
    y = y.transpose(1, 2, 0, 3, 4)
    y = y[0] + _seg_flip(y[1], n_ctx, 1)
    if not need_ctx:
        y, r, k, v, g = (a[:, n_ctx:] for a in (y, r, k, v, g))

    def heads(a):
        return a.astype(F32).reshape(a.shape[0], a.shape[1], RWKV_HEADS, RWKV_HEAD_DIM)

    mean = jnp.mean(y, axis=-1, keepdims=True)
    var = jnp.mean(jnp.square(y - mean), axis=-1, keepdims=True)
    yn = ((y - mean) * lax.rsqrt(var + RWKV_GN_EPS)
          * ln_w.astype(F32).reshape(RWKV_HEADS, RWKV_HEAD_DIM)
          + ln_b.astype(F32).reshape(RWKV_HEADS, RWKV_HEAD_DIM))
    bonus = jnp.sum(heads(r) * heads(k) * r_k.astype(F32), axis=-1, keepdims=True) * heads(v)
    o = (yn + bonus).reshape(bsz, -1, D_INNER) * jax.nn.silu(g.astype(F32))
    o = o.astype(dt) @ w_out
    if need_ctx:
        return o[:, :n_ctx], o[:, n_ctx:]
    return None, o


def _na_mixer(hc, hx, w_in, q_g, k_g, rpb, w_out, need_ctx):
    dt = hx.dtype
    bsz, n_lat, _ = hx.shape
    n_ctx = hc.shape[1]
    rows = n_lat // GRID_W
    kh = min(NA_KH_MAX, rows)
    n_nb = kh * NA_KW
    scale = NA_HEAD_DIM ** -0.5

    def project(h):
        q, k, v, z = jnp.split(h @ w_in, 4, axis=-1)
        split = lambda a: a.reshape(a.shape[0], a.shape[1], NA_HEADS, NA_HEAD_DIM)
        return _head_rms(split(q), q_g), _head_rms(split(k), k_g), split(v), z

    qc, kc, vc, zc = project(hc)
    qx, kx, vx, zx = project(hx)
    kc_h = kc.transpose(0, 2, 1, 3)
    vc_h = vc.transpose(0, 2, 1, 3)
    grid = lambda a: a.reshape(bsz, rows, GRID_W, NA_HEADS, NA_HEAD_DIM).transpose(0, 3, 1, 2, 4)
    qg, kg, vg = grid(qx), grid(kx), grid(vx)

    row_start = jnp.clip(jnp.arange(rows) - kh // 2, 0, rows - kh)
    cols = jnp.arange(GRID_W)
    col_idx = (jnp.clip(cols - NA_KW // 2, 0, GRID_W - NA_KW)[:, None]
               + jnp.arange(NA_KW)[None, :])
    rpb_cols = rpb[:, :, col_idx - cols[:, None] + NA_KW - 1].astype(F32)

    def row_block(i):
        r0 = row_start[i]
        qi = lax.dynamic_index_in_dim(qg, i, axis=2, keepdims=False)
        k_nb = lax.dynamic_slice_in_dim(kg, r0, kh, axis=2)[:, :, :, col_idx]
        v_nb = lax.dynamic_slice_in_dim(vg, r0, kh, axis=2)[:, :, :, col_idx]
        bias = jnp.take(rpb_cols, r0 + jnp.arange(kh) - i + NA_KH_MAX - 1,
                        axis=1).transpose(0, 2, 1, 3)
        s_nb = jnp.einsum("bhqd,bhrqcd->bhqrc", qi, k_nb).astype(F32) * scale + bias[None]
        s_ctx = jnp.einsum("bhqd,bhld->bhql", qi, kc_h).astype(F32) * scale
        p = jax.nn.softmax(jnp.concatenate(
            [s_nb.reshape(bsz, NA_HEADS, GRID_W, n_nb), s_ctx], axis=-1), axis=-1).astype(dt)
        p_nb = p[..., :n_nb].reshape(bsz, NA_HEADS, GRID_W, kh, NA_KW)
        return (jnp.einsum("bhqrc,bhrqcd->bhqd", p_nb, v_nb)
                + jnp.einsum("bhql,bhld->bhqd", p[..., n_nb:], vc_h))

    o_x = lax.map(row_block, jnp.arange(rows))
    o_x = o_x.transpose(1, 0, 3, 2, 4).reshape(bsz, n_lat, D_INNER)
    out_x = (o_x * jax.nn.silu(zx)) @ w_out
    if not need_ctx:
        return None, out_x
    qc_h = qc.transpose(0, 2, 1, 3)
    p_c = jax.nn.softmax(jnp.einsum("bhqd,bhkd->bhqk", qc_h, kc_h).astype(F32) * scale,
                         axis=-1).astype(dt)
    o_c = jnp.einsum("bhqk,bhkd->bhqd", p_c, vc_h).transpose(0, 2, 1, 3).reshape(bsz, n_ctx, D_INNER)
    return (o_c * jax.nn.silu(zc)) @ w_out, out_x


def _s5_mixer(hc, hx, w_in, lam_re, lam_im, log_dt, b_re, b_im, c_re, c_im, d_skip,
              w_glu, b_glu, w_out, need_ctx):
    dt = hx.dtype
    n_ctx = hc.shape[1]
    h = jnp.concatenate([hc, hx], axis=1)
    bsz, t_all, _ = h.shape
    u, z = jnp.split(h @ w_in, 2, axis=-1)
    u_t = jnp.swapaxes(u.astype(F32).reshape(bsz, t_all, S5_GROUPS, S5_GROUP), 0, 1)
    br, bi = b_re.astype(F32), b_im.astype(F32)
    cr, ci = c_re.astype(F32), c_im.astype(F32)
    y = jnp.zeros_like(u_t)
    for s in range(2):
        lr, li = lam_re[s].astype(F32), lam_im[s].astype(F32)
        step = jnp.exp(log_dt[s].astype(F32))[:, None]
        mag = jnp.exp(lr * step)
        ar, ai = mag * jnp.cos(li * step), mag * jnp.sin(li * step)
        den = lr * lr + li * li
        qr = ((ar - 1.0) * lr + ai * li) / den
        qi = (ai * lr - (ar - 1.0) * li) / den
        bbr = qr[..., None] * br - qi[..., None] * bi
        bbi = qr[..., None] * bi + qi[..., None] * br
        u_s = u_t if s == 0 else _seg_flip(u_t, n_ctx, 0)
        bu_r = jnp.einsum("gpc,tbgc->tbgp", bbr, u_s)
        bu_i = jnp.einsum("gpc,tbgc->tbgp", bbi, u_s)
        a_shape = (t_all, 1, S5_GROUPS, S5_STATE)
        _, _, xr, xi = lax.associative_scan(
            _complex_affine_combine,
            (jnp.broadcast_to(ar, a_shape), jnp.broadcast_to(ai, a_shape), bu_r, bu_i), axis=0)
        y_s = jnp.einsum("gcp,tbgp->tbgc", cr, xr) - jnp.einsum("gcp,tbgp->tbgc", ci, xi)
        y = y + (y_s if s == 0 else _seg_flip(y_s, n_ctx, 0))
    y = jnp.swapaxes(y, 0, 1).reshape(bsz, t_all, D_INNER) + d_skip.astype(F32) * u.astype(F32)
    if not need_ctx:
        y, z = y[:, n_ctx:], z[:, n_ctx:]
    y = jax.nn.gelu(y).astype(dt)
    y = y * jax.nn.sigmoid(y @ w_glu + b_glu)
    o = (y * jax.nn.silu(z)) @ w_out
    if need_ctx:
        return o[:, :n_ctx], o[:, n_ctx:]
    return None, o


def setup_inputs(seed: int = 0) -> dict:
    key = jax.random.key(seed)
    keys = iter(jax.random.split(key, 64))
    nrm = lambda shape, s: jax.random.normal(next(keys), shape, F32) * s
    D, E = D_MODEL, D_INNER
    na, nb, nc = N_LAYERS_RWKV, N_LAYERS_NA, N_LAYERS_S5
    inp = {}
    inp["x"] = nrm((BATCH, SEQ, D), 1.0)
    inp["c"] = nrm((BATCH, D), 1.0)
    inp["ctx"] = nrm((BATCH, CTX_LEN, D), 1.0)
    inp["c_ctx"] = nrm((D,), 1.0)
    inp["norm_g"] = 1.0 + nrm((DEPTH, D), 0.02)
    inp["w_mod"] = nrm((DEPTH, D, 3 * D), 0.5 * D ** -0.5)
    inp["b_mod"] = nrm((DEPTH, 3 * D), 0.02)
    inp["rwkv_mu"] = jax.random.uniform(next(keys), (na, RWKV_N_MIX, D), F32)
    inp["rwkv_w_rkvg"] = nrm((na, 4, D, E), D ** -0.5)
    ramp = -6.0 + 5.0 * jnp.linspace(0.0, 1.0, E, dtype=F32)
    inp["rwkv_w0"] = ramp[None, None, :] + nrm((na, 2, E), 0.1)
    inp["rwkv_w1"] = nrm((na, 2, D, RWKV_DECAY_LORA), D ** -0.5)
    inp["rwkv_w2"] = nrm((na, 2, RWKV_DECAY_LORA, E), 0.1 * RWKV_DECAY_LORA ** -0.5)
    inp["rwkv_a0"] = nrm((na, 2, E), 0.1)
    inp["rwkv_a1"] = nrm((na, 2, D, RWKV_ICLR_LORA), D ** -0.5)
    inp["rwkv_a2"] = nrm((na, 2, RWKV_ICLR_LORA, E), 0.1 * RWKV_ICLR_LORA ** -0.5)
    inp["rwkv_k_k"] = 0.85 + nrm((na, E), 0.02)
    inp["rwkv_k_a"] = 1.0 + nrm((na, E), 0.02)
    inp["rwkv_r_k"] = nrm((na, RWKV_HEADS, RWKV_HEAD_DIM), 0.1)
    inp["rwkv_ln_w"] = 1.0 + nrm((na, E), 0.02)
    inp["rwkv_ln_b"] = nrm((na, E), 0.02)
    inp["rwkv_w_out"] = nrm((na, E, D), E ** -0.5)
    inp["na_w_in"] = nrm((nb, D, 4 * E), D ** -0.5)
    inp["na_q_g"] = 1.0 + nrm((nb, NA_HEAD_DIM), 0.02)
    inp["na_k_g"] = 1.0 + nrm((nb, NA_HEAD_DIM), 0.02)
    inp["na_rpb"] = nrm((nb, NA_HEADS, 2 * NA_KH_MAX - 1, 2 * NA_KW - 1), 0.1)
    inp["na_w_out"] = nrm((nb, E, D), E ** -0.5)
    inp["s5_w_in"] = nrm((nc, D, 2 * E), D ** -0.5)
    inp["s5_lam_re"] = -0.5 + nrm((nc, 2, S5_GROUPS, S5_STATE), 0.01)
    inp["s5_lam_im"] = (math.pi * jnp.arange(S5_STATE, dtype=F32))[None, None, None, :] + nrm(
        (nc, 2, S5_GROUPS, S5_STATE), 0.01)
    inp["s5_log_dt"] = jax.random.uniform(next(keys), (nc, 2, S5_GROUPS), F32,
                                          math.log(S5_DT_MIN), math.log(S5_DT_MAX))
    inp["s5_b_re"] = nrm((nc, S5_GROUPS, S5_STATE, S5_GROUP), (2 * S5_GROUP) ** -0.5)
    inp["s5_b_im"] = nrm((nc, S5_GROUPS, S5_STATE, S5_GROUP), (2 * S5_GROUP) ** -0.5)
    inp["s5_c_re"] = nrm((nc, S5_GROUPS, S5_GROUP, S5_STATE), S5_STATE ** -0.5)
    inp["s5_c_im"] = nrm((nc, S5_GROUPS, S5_GROUP, S5_STATE), S5_STATE ** -0.5)
    inp["s5_d"] = nrm((nc, E), 0.5)
    inp["s5_w_glu"] = nrm((nc, E, E), E ** -0.5)
    inp["s5_b_glu"] = nrm((nc, E), 0.02)
    inp["s5_w_out"] = nrm((nc, E, D), E ** -0.5)
    return inp


def reference(x, c, ctx, c_ctx, norm_g, w_mod, b_mod,
              rwkv_mu, rwkv_w_rkvg, rwkv_w0, rwkv_w1, rwkv_w2, rwkv_a0, rwkv_a1, rwkv_a2,
              rwkv_k_k, rwkv_k_a, rwkv_r_k, rwkv_ln_w, rwkv_ln_b, rwkv_w_out,
              na_w_in, na_q_g, na_k_g, na_rpb, na_w_out,
              s5_w_in, s5_lam_re, s5_lam_im, s5_log_dt, s5_b_re, s5_b_im, s5_c_re, s5_c_im,
              s5_d, s5_w_glu, s5_b_glu, s5_w_out):
    dt = x.dtype
    silu_c = jax.nn.silu(c.astype(F32))
    silu_cc = jax.nn.silu(c_ctx.astype(F32))
    for i in range(DEPTH):
        kind, j = i % N_MIXERS, i // N_MIXERS
        need_ctx = i < DEPTH - 1
        wm, bm = w_mod[i].astype(F32), b_mod[i].astype(F32)
        mod_x = (silu_c @ wm + bm).astype(dt)
        mod_c = (silu_cc @ wm + bm).astype(dt)
        shift_x, scale_x, gate_x = jnp.split(mod_x[:, None, :], 3, axis=-1)
        shift_c, scale_c, gate_c = jnp.split(mod_c, 3, axis=-1)
        hx = _rms_norm(x, norm_g[i]) * (1.0 + scale_x) + shift_x
        hc = _rms_norm(ctx, norm_g[i]) * (1.0 + scale_c) + shift_c
        if kind == 0:
            oc, ox = _rwkv7_mixer(hc, hx, rwkv_mu[j], rwkv_w_rkvg[j], rwkv_w0[j], rwkv_w1[j],
                                  rwkv_w2[j], rwkv_a0[j], rwkv_a1[j], rwkv_a2[j], rwkv_k_k[j],
                                  rwkv_k_a[j], rwkv_r_k[j], rwkv_ln_w[j], rwkv_ln_b[j],
                                  rwkv_w_out[j], need_ctx)
        elif kind == 1:
            oc, ox = _na_mixer(hc, hx, na_w_in[j], na_q_g[j], na_k_g[j], na_rpb[j],
                               na_w_out[j], need_ctx)
        else:
            oc, ox = _s5_mixer(hc, hx, s5_w_in[j], s5_lam_re[j], s5_lam_im[j], s5_log_dt[j],
                               s5_b_re[j], s5_b_im[j], s5_c_re[j], s5_c_im[j], s5_d[j],
                               s5_w_glu[j], s5_b_glu[j], s5_w_out[j], need_ctx)
        x = x + gate_x * ox
        if need_ctx:
            ctx = ctx + gate_c * oc
    return x
```

```cpp
#include <hip/hip_runtime.h>
#include <hip/hip_cooperative_groups.h>
#include <cstdio>
#include <cstdint>
namespace cg = cooperative_groups;

namespace pg8 {
#define PG8_LAS __attribute__((address_space(3)))
typedef unsigned short bf16_t;
typedef short bf16x8 __attribute__((ext_vector_type(8)));
typedef float f32x4 __attribute__((ext_vector_type(4)));
typedef unsigned u32x4 __attribute__((ext_vector_type(4)));
constexpr int BM = 256, BK = 64, HALF = 128, HTB = HALF * BK * 2  , STAGE_BYTES = 8 * HTB, NXCD = 8, WGM = 8;

__host__ __device__ __forceinline__ int lds_byte(int r, int c) { const int st = (r >> 4) * 2 + (c >> 5), rr = r & 15, cc = c & 31, ob = rr * 64 + cc * 2; return st * 1024 + (ob ^ (((ob >> 9) & 1) << 5)); }
__host__ __device__ __forceinline__ void stage_rc(int b, int& R, int& C) { const int st = b / 1024, sb = b % 1024, swz = sb ^ (((sb >> 9) & 1) << 5); R = (st >> 1) * 16 + swz / 64; C = (st & 1) * 32 + (swz % 64) / 2; }
__host__ __device__ __forceinline__ int perm32(int rho) { const int n = rho >> 4, i = rho & 15; return 8 * (i >> 2) + 4 * n + (i & 3); }

struct Unit { int pm, pn; };
struct Gemm { const bf16_t* A; const bf16_t* Bt; int M, N, K; };

struct ListOrder {
    int n, G, c, mode, nN;
    __device__ __forceinline__ bool next(int i, Unit& u) const {
        const int L = i * G + c; if (L >= n) return false;
        if (mode == 0) { u.pm = L / nN; u.pn = L - u.pm * nN; }
        else if (mode == 1) {
            if (L < 544) { const int nn = L / 272, rem = L - nn * 272; u.pm = nn * 68 + (rem >> 2); u.pn = nn * 4 + (rem & 3); }
            else { const int Lp = L - 544, nn = 2 + Lp / 68; u.pm = nn * 68 + Lp % 68; u.pn = 8 + (nn - 2); }
        } else { const int nn = L / 272, rem = L - nn * 272; u.pm = nn * 68 + (rem >> 2); u.pn = nn * 4 + (rem & 3); }
        return true;
    }
    __device__ __forceinline__ void a_ready(const Unit&) const {}
    __device__ __forceinline__ void done(const Unit&) const {}
};
template <class F> struct EpiT {
    static constexpr bool PERM = true, AFTER_DRAIN = false;
    F f;
    __device__ __forceinline__ void operator()(const f32x4 (&acc)[2][2][4][2], const Unit& u, int wr, int wc, int fr, int fq) const {
#pragma unroll
        for (int ai = 0; ai < 2; ++ai)
#pragma unroll
            for (int m = 0; m < 4; ++m)
#pragma unroll
                for (int bj = 0; bj < 2; ++bj) f(u, ai * 128 + wr * 64 + m * 16 + fr, bj * 128 + wc * 32 + 8 * fq, acc[ai][bj][m][0], acc[ai][bj][m][1]);
    }
};
template <class Epi, class Sched, bool ALIGN_EPI = false, bool SP2 = false>
__device__ __forceinline__ void gemm_phase(PG8_LAS unsigned char* lds, const Gemm g, const Sched& S, const Epi& E) {
    const int tid = threadIdx.x, wid = __builtin_amdgcn_readfirstlane(tid >> 6), lane = tid & 63, wr = wid >> 2, wc = wid & 3, fr = lane & 15, fq = lane >> 4;
    const int K = g.K, nt = K / BK;
    unsigned voffA[2], voffB[2];
#pragma unroll
    for (int i = 0; i < 2; ++i) { int R, C; stage_rc(tid * 16 + i * 8192, R, C); const int Rb = Epi::PERM ? ((R & ~31) + perm32(R & 31)) : R;
        voffA[i] = (unsigned)(R * K + C) * 2u; voffB[i] = (unsigned)(Rb * K + C) * 2u; }
    const size_t kstep = (size_t)(BK * 2);
    const size_t hstep = (size_t)HALF * K * 2;
    const size_t tstep = 2 * hstep;
    const unsigned ldsw = (unsigned)wid * 1024u;
    const int aoff = lds_byte(wr * 64 + fr, fq * 8), boff = lds_byte(wc * 32 + fr, fq * 8);
#define PG8_SA(b, h) (((b) * 2 + (h)) * HTB)
#define PG8_SB(b, h) ((4 + (b) * 2 + (h)) * HTB)
#define PG8_STAGE(bufoff, gbase, voff) do { _Pragma("unroll") for (int _i = 0; _i < 2; ++_i) \
        __builtin_amdgcn_global_load_lds((const unsigned*)((const char*)(gbase) + (voff)[_i]), (PG8_LAS unsigned*)(lds + (bufoff) + ldsw + _i * 8192), 16, 0, 0); } while (0)
#define PG8_LDA(dst, b, h) do { _Pragma("unroll") for (int m = 0; m < 4; ++m) _Pragma("unroll") for (int k = 0; k < 2; ++k) dst[m][k] = *(const PG8_LAS bf16x8*)(lds + PG8_SA(b, h) + aoff + m * 2048 + k * 1024); } while (0)
#define PG8_LDB(dst, b, h) do { _Pragma("unroll") for (int n = 0; n < 2; ++n) _Pragma("unroll") for (int k = 0; k < 2; ++k) dst[n][k] = *(const PG8_LAS bf16x8*)(lds + PG8_SB(b, h) + boff + n * 2048 + k * 1024); } while (0)
#define PG8_MMA(ai, bj, At, Bt) do { __builtin_amdgcn_s_setprio(1); _Pragma("unroll") for (int m = 0; m < 4; ++m) _Pragma("unroll") for (int n = 0; n < 2; ++n) _Pragma("unroll") for (int k = 0; k < 2; ++k) \
        acc[ai][bj][m][n] = __builtin_amdgcn_mfma_f32_16x16x32_bf16(Bt[n][k], At[m][k], acc[ai][bj][m][n], 0, 0, 0); __builtin_amdgcn_s_setprio(0); } while (0)
#define PG8_WAIT_V(n) asm volatile("s_waitcnt vmcnt(" #n ")" ::: "memory")
#define PG8_WAIT_L(n) asm volatile("s_waitcnt lgkmcnt(" #n ")" ::: "memory")
#define PG8_BAR __builtin_amdgcn_s_barrier()
#define PG8_SCHED __builtin_amdgcn_sched_barrier(0)
    Unit cur, nxt; int ui = 0;
    if (!S.next(0, cur)) return;
    f32x4 acc[2][2][4][2];
#pragma unroll
    for (int a = 0; a < 2; ++a)
#pragma unroll
        for (int b = 0; b < 2; ++b)
#pragma unroll
            for (int m = 0; m < 4; ++m)
#pragma unroll
                for (int n = 0; n < 2; ++n) acc[a][b][m][n] = (f32x4){0.f, 0.f, 0.f, 0.f};
    bf16x8 At[4][2], B0[2][2], B1[2][2];
    const char* cA = (const char*)g.A + (size_t)cur.pm * tstep; const char* cB = (const char*)g.Bt + (size_t)cur.pn * tstep;
    S.a_ready(cur);
    if constexpr (SP2) {
        PG8_STAGE(PG8_SB(0, 0), cB, voffB); PG8_STAGE(PG8_SB(0, 1), cB + hstep, voffB); PG8_STAGE(PG8_SA(0, 0), cA, voffA); PG8_STAGE(PG8_SA(0, 1), cA + hstep, voffA);
        if (wr == 1) PG8_BAR;
        PG8_WAIT_V(2); PG8_BAR;
        PG8_STAGE(PG8_SB(1, 0), cB + kstep, voffB); PG8_STAGE(PG8_SA(1, 0), cA + kstep, voffA); PG8_STAGE(PG8_SB(1, 1), cB + hstep + kstep, voffB);
        PG8_WAIT_V(6); PG8_BAR;
    } else {
        PG8_STAGE(PG8_SB(0, 0), cB, voffB); PG8_STAGE(PG8_SA(0, 0), cA, voffA); PG8_STAGE(PG8_SB(0, 1), cB + hstep, voffB); PG8_STAGE(PG8_SA(0, 1), cA + hstep, voffA);
        if (wr == 1) PG8_BAR;
        PG8_WAIT_V(4); PG8_BAR;
        PG8_STAGE(PG8_SB(1, 0), cB + kstep, voffB); PG8_STAGE(PG8_SA(1, 0), cA + kstep, voffA); PG8_STAGE(PG8_SB(1, 1), cB + hstep + kstep, voffB);
        PG8_WAIT_V(6); PG8_BAR;
    }
    for (;;) {
        const bool has_next = S.next(ui + 1, nxt);
        const char* nA = has_next ? (const char*)g.A + (size_t)nxt.pm * tstep : cA; const char* nB = has_next ? (const char*)g.Bt + (size_t)nxt.pn * tstep : cB;
        for (int t = 0; t < nt; t += 2) {
            const bool last = (t == nt - 2);
            const char* a1 = cA + (size_t)(t + 1) * kstep;
            const char* a2 = last ? nA : cA + (size_t)(t + 2) * kstep; const char* b2 = last ? nB : cB + (size_t)(t + 2) * kstep;
            const char* a3 = a2 + kstep; const char* b3 = b2 + kstep;
            if (last && has_next) S.a_ready(nxt);
            if constexpr (SP2) {
            PG8_LDB(B0, 0, 0); PG8_LDB(B1, 0, 1); PG8_SCHED; PG8_LDA(At, 0, 0); PG8_STAGE(PG8_SA(1, 1), a1 + hstep, voffA);
            PG8_WAIT_V(8); PG8_WAIT_L(0); PG8_BAR; PG8_MMA(0, 0, At, B0); PG8_MMA(0, 1, At, B1); PG8_BAR; PG8_SCHED;
            PG8_LDA(At, 0, 1); PG8_STAGE(PG8_SB(0, 0), b2, voffB); PG8_STAGE(PG8_SB(0, 1), b2 + hstep, voffB); PG8_STAGE(PG8_SA(0, 0), a2, voffA);
            PG8_WAIT_V(8); PG8_WAIT_L(0); PG8_BAR; PG8_MMA(1, 0, At, B0); PG8_MMA(1, 1, At, B1); PG8_BAR; PG8_SCHED;
            PG8_LDB(B0, 1, 0); PG8_LDB(B1, 1, 1); PG8_SCHED; PG8_LDA(At, 1, 0); PG8_STAGE(PG8_SA(0, 1), a2 + hstep, voffA);
            PG8_WAIT_V(8); PG8_WAIT_L(0); PG8_BAR; PG8_MMA(0, 0, At, B0); PG8_MMA(0, 1, At, B1); PG8_BAR; PG8_SCHED;
            PG8_LDA(At, 1, 1); PG8_STAGE(PG8_SB(1, 0), b3, voffB); PG8_STAGE(PG8_SB(1, 1), b3 + hstep, voffB); PG8_STAGE(PG8_SA(1, 0), a3, voffA);
            PG8_WAIT_V(8); PG8_WAIT_L(0); PG8_BAR; PG8_MMA(1, 0, At, B0); PG8_MMA(1, 1, At, B1); PG8_BAR; PG8_SCHED;
            } else {
            PG8_LDB(B0, 0, 0); PG8_SCHED; PG8_LDA(At, 0, 0); PG8_STAGE(PG8_SA(1, 1), a1 + hstep, voffA);
            PG8_WAIT_L(8); PG8_BAR; PG8_WAIT_L(0); PG8_MMA(0, 0, At, B0); PG8_BAR; PG8_SCHED;
            PG8_LDB(B1, 0, 1); PG8_STAGE(PG8_SB(0, 0), b2, voffB);
            PG8_BAR; PG8_WAIT_L(0); PG8_MMA(0, 1, At, B1); PG8_BAR;
            PG8_LDA(At, 0, 1); PG8_STAGE(PG8_SA(0, 0), a2, voffA);
            PG8_BAR; PG8_WAIT_L(0); PG8_MMA(1, 0, At, B0); PG8_BAR; PG8_SCHED;
            PG8_STAGE(PG8_SB(0, 1), b2 + hstep, voffB);
            PG8_WAIT_V(6); PG8_BAR; PG8_MMA(1, 1, At, B1); PG8_BAR;
            PG8_LDB(B0, 1, 0); PG8_SCHED; PG8_LDA(At, 1, 0); PG8_STAGE(PG8_SA(0, 1), a2 + hstep, voffA);
            PG8_WAIT_L(8); PG8_BAR; PG8_WAIT_L(0); PG8_MMA(0, 0, At, B0); PG8_BAR; PG8_SCHED;
            PG8_LDB(B1, 1, 1); PG8_STAGE(PG8_SB(1, 0), b3, voffB);
            PG8_BAR; PG8_WAIT_L(0); PG8_MMA(0, 1, At, B1); PG8_BAR;
            PG8_LDA(At, 1, 1); PG8_STAGE(PG8_SA(1, 0), a3, voffA);
            PG8_BAR; PG8_WAIT_L(0); PG8_MMA(1, 0, At, B0); PG8_BAR; PG8_SCHED;
            PG8_STAGE(PG8_SB(1, 1), b3 + hstep, voffB);
            PG8_WAIT_V(6); PG8_BAR; PG8_MMA(1, 1, At, B1); PG8_BAR;
            }
        }
        if constexpr (ALIGN_EPI) { if (wr == 0) PG8_BAR; }
        if constexpr (!Epi::AFTER_DRAIN) { E(acc, cur, wr, wc, fr, fq); S.done(cur); }
        if (!has_next) break;
#pragma unroll
        for (int a = 0; a < 2; ++a)
#pragma unroll
            for (int b = 0; b < 2; ++b)
#pragma unroll
                for (int m = 0; m < 4; ++m)
#pragma unroll
                    for (int n = 0; n < 2; ++n) acc[a][b][m][n] = (f32x4){0.f, 0.f, 0.f, 0.f};
        cur = nxt; cA = nA; cB = nB; ++ui;
        if constexpr (ALIGN_EPI) { if (wr == 1) PG8_BAR; }
    }
    PG8_WAIT_V(0);
    if constexpr (!ALIGN_EPI) { if (wr == 0) PG8_BAR; }
    PG8_BAR;
    if constexpr (Epi::AFTER_DRAIN) { E.fused(acc, cur, wr, wc, fr, fq, lds, wid, lane); S.done(cur); }
#undef PG8_SA
#undef PG8_SB
#undef PG8_STAGE
#undef PG8_LDA
#undef PG8_LDB
#undef PG8_MMA
#undef PG8_WAIT_V
#undef PG8_WAIT_L
#undef PG8_BAR
#undef PG8_SCHED
}
}

constexpr int NB = 4, SEQ = 4096, CTXL = 256, TB = SEQ + CTXL  , NT = NB * TB  , D = 1024, NMT = NT / 256  ;
constexpr int NWAVES = 8, NTHR = 512, GRID = 256;
constexpr size_t MiB = 1u << 20;
constexpr size_t OFF_MOD = 0, OFF_S5A = 256 * 1024, OFF_BB = 1 * MiB, OFF_L2T = 2 * MiB, OFF_CTX = 3 * MiB, OFF_WT = 7 * MiB, OFF_R0 = 18 * MiB, RSZ = 34 * MiB;
constexpr size_t WS_NEED = OFF_R0 + 7 * RSZ;
constexpr int LDS_BYTES = 147456;

typedef unsigned short bf16;
typedef float f32x4 __attribute__((ext_vector_type(4)));
typedef short bf16x8 __attribute__((ext_vector_type(8)));
typedef unsigned u32x4 __attribute__((ext_vector_type(4)));
typedef unsigned u32x2 __attribute__((ext_vector_type(2)));

__device__ __forceinline__ float bf2f(unsigned v) { return __builtin_bit_cast(float, v << 16); }
__device__ __forceinline__ unsigned f2bf(float f) { unsigned u = __builtin_bit_cast(unsigned, f); return (u + 0x7fffu + ((u >> 16) & 1u)) >> 16; }
__device__ __forceinline__ unsigned pk2(float lo, float hi) { return f2bf(lo) | (f2bf(hi) << 16); }
__device__ __forceinline__ float lo_bf(unsigned w) { return __builtin_bit_cast(float, w << 16); }
__device__ __forceinline__ float hi_bf(unsigned w) { return __builtin_bit_cast(float, w & 0xffff0000u); }
__device__ __forceinline__ void store8(bf16* p, f32x4 a, f32x4 b) { u32x4 w; w.x = pk2(a.x, a.y); w.y = pk2(a.z, a.w); w.z = pk2(b.x, b.y); w.w = pk2(b.z, b.w); *(u32x4*)p = w; }
__device__ __forceinline__ float sigm(float x) { return 1.f / (1.f + __expf(-x)); }
__device__ __forceinline__ float silu(float x) { return x / (1.f + __expf(-x)); }
template <int CTRL> __device__ __forceinline__ float dppf(float x) { return __builtin_bit_cast(float, __builtin_amdgcn_update_dpp(0, __builtin_bit_cast(int, x), CTRL, 0xF, 0xF, false)); }
__device__ __forceinline__ float allred16(float x) { x += dppf<0x128>(x); x += dppf<0x124>(x); x += dppf<0x122>(x); x += dppf<0x121>(x); return x; }
__device__ __forceinline__ float wave_sum(float v) {
#pragma unroll
    for (int o = 1; o < 64; o <<= 1) v += __shfl_xor(v, o);
    return v;
}
__device__ __forceinline__ int tokof(int s, int q) { return s == 0 ? q : (q < CTXL ? (CTXL - 1 - q) : (TB + CTXL - 1 - q)); }

struct Args { const float* in[38]; float* out; unsigned char* ws; int ph_lo, ph_hi; };

struct Fr {
    const Args* a; unsigned char* lds; unsigned char* ws; int tid, lane, wave, gw;
    __device__ __forceinline__ bf16* R(int i) const { return (bf16*)(ws + OFF_R0 + (size_t)i * RSZ); }
    __device__ __forceinline__ float* mod(int l) const { return (float*)(ws + OFF_MOD) + l * 5 * 3072; }
    __device__ __forceinline__ bf16* WT() const { return (bf16*)(ws + OFF_WT); }
    __device__ __forceinline__ float* ctxbuf() const { return (float*)(ws + OFF_CTX); }
};
__device__ __forceinline__ const float* xrow(const Fr& F, int l, int m) {
    const int b = m / TB, t = m - b * TB;
    if (t < CTXL) return (l == 0 ? F.a->in[2] : F.ctxbuf()) + (size_t)(b * CTXL + t) * D;
    return (l == 0 ? F.a->in[0] : F.a->out) + (size_t)(b * SEQ + t - CTXL) * D;
}

struct FRkv {
    bf16* o0; bf16* o1; bf16* lm;
    __device__ __forceinline__ void operator()(const pg8::Unit& u, int rl, int cl, f32x4 v0, f32x4 v1) const {
        const int nn = u.pm / NMT, pm = u.pm - nn * NMT; const size_t row = (size_t)pm * 256 + rl;
        if (nn < 2) { const int col = (u.pn - nn * 4) * 256 + cl; store8((nn ? o1 : o0) + row * D + col, v0, v1); }
        else if (cl < 128) {
            if (nn == 2) { v0.x = tanhf(v0.x); v0.y = tanhf(v0.y); v0.z = tanhf(v0.z); v0.w = tanhf(v0.w); v1.x = tanhf(v1.x); v1.y = tanhf(v1.y); v1.z = tanhf(v1.z); v1.w = tanhf(v1.w); }
            store8(lm + row * 256 + (nn - 2) * 128 + cl, v0, v1);
        }
    }
};
struct FResid {
    const float* xo; const float* co; float* xn; float* cn; const float* modl;
    __device__ __forceinline__ void operator()(const pg8::Unit& u, int rl, int cl, f32x4 v0, f32x4 v1) const {
        const int b = u.pm / 17, j = u.pm - 17 * b, col = u.pn * 256 + cl;
        const float* src; float* dst; const float* gate;
        if (j == 0) { const size_t off = (size_t)(b * CTXL + rl) * D + col; src = co + off; dst = cn + off; gate = modl + 4 * 3072 + 2048 + col; }
        else { const size_t off = (size_t)(b * SEQ + (j - 1) * 256 + rl) * D + col; src = xo + off; dst = xn + off; gate = modl + b * 3072 + 2048 + col; }
        const f32x4 a0 = *(const f32x4*)src, a1 = *(const f32x4*)(src + 4), g0 = *(const f32x4*)gate, g1 = *(const f32x4*)(gate + 4);
        *(f32x4*)dst = a0 + g0 * v0; *(f32x4*)(dst + 4) = a1 + g1 * v1;
    }
};
struct FNaIn {
    bf16* q; bf16* k; bf16* vt; bf16* z;
    __device__ __forceinline__ void operator()(const pg8::Unit& u, int rl, int cl, f32x4 v0, f32x4 v1) const {
        const int sel = u.pn >> 2, col = (u.pn & 3) * 256 + cl; const size_t row = (size_t)u.pm * 256 + rl;
        if (sel == 2) {
            const int b = u.pm / 17, t = (u.pm - 17 * b) * 256 + rl, head = col >> 6, d = col & 63;
            bf16* p = vt + ((size_t)(b * 16 + head) * 64 + d) * TB + t;
            p[0] = (bf16)f2bf(v0.x); p[TB] = (bf16)f2bf(v0.y); p[2 * TB] = (bf16)f2bf(v0.z); p[3 * TB] = (bf16)f2bf(v0.w);
            p[4 * TB] = (bf16)f2bf(v1.x); p[5 * TB] = (bf16)f2bf(v1.y); p[6 * TB] = (bf16)f2bf(v1.z); p[7 * TB] = (bf16)f2bf(v1.w);
        } else { bf16* o = q + (size_t)sel * (RSZ / 2); store8(o + row * D + col, v0, v1); }
    }
};
struct FS5In {
    float* uo; bf16* z;
    __device__ __forceinline__ void operator()(const pg8::Unit& u, int rl, int cl, f32x4 v0, f32x4 v1) const {
        const size_t row = (size_t)u.pm * 256 + rl;
        if (u.pn < 4) { float* p = uo + row * D + u.pn * 256 + cl; *(f32x4*)p = v0; *(f32x4*)(p + 4) = v1; }
        else store8(z + row * D + (u.pn - 4) * 256 + cl, v0, v1);
    }
};
struct FGlu {
    const bf16* y; const bf16* z; const float* bias; bf16* o;
    __device__ __forceinline__ void operator()(const pg8::Unit& u, int rl, int cl, f32x4 v0, f32x4 v1) const {
        const int col = u.pn * 256 + cl; const size_t off = ((size_t)u.pm * 256 + rl) * D + col;
        const u32x4 yw = *(const u32x4*)(y + off), zw = *(const u32x4*)(z + off);
        const f32x4 b0 = *(const f32x4*)(bias + col), b1 = *(const f32x4*)(bias + col + 4);
        f32x4 r0, r1;
        r0.x = lo_bf(yw.x) * sigm(v0.x + b0.x) * silu(lo_bf(zw.x)); r0.y = hi_bf(yw.x) * sigm(v0.y + b0.y) * silu(hi_bf(zw.x));
        r0.z = lo_bf(yw.y) * sigm(v0.z + b0.z) * silu(lo_bf(zw.y)); r0.w = hi_bf(yw.y) * sigm(v0.w + b0.w) * silu(hi_bf(zw.y));
        r1.x = lo_bf(yw.z) * sigm(v1.x + b1.x) * silu(lo_bf(zw.z)); r1.y = hi_bf(yw.z) * sigm(v1.y + b1.y) * silu(hi_bf(zw.z));
        r1.z = lo_bf(yw.w) * sigm(v1.z + b1.z) * silu(lo_bf(zw.w)); r1.w = hi_bf(yw.w) * sigm(v1.w + b1.w) * silu(hi_bf(zw.w));
        store8(o + off, r0, r1);
    }
};

template <class F> __device__ __forceinline__ void run_gemm(const Fr& Fm, const bf16* A, const bf16* Bt, int K, int nunits, int mode, int nN, const F& f) {
    pg8::Gemm g{A, Bt, 0, 0, K}; pg8::ListOrder S{nunits, (int)gridDim.x, (int)blockIdx.x, mode, nN}; pg8::EpiT<F> E{f};
    pg8::gemm_phase<pg8::EpiT<F>, pg8::ListOrder, true, true>((PG8_LAS unsigned char*)Fm.lds, g, S, E);
}

__device__ __forceinline__ void transpose_item(const float* W, int K, int N, bf16* WT, int row_off, float* scr, int item, int lane) {
    const int nblk = N / 32, kb = item / nblk, nb = item % nblk, k0 = 64 * kb, n0 = 32 * nb;
#pragma unroll 8
    for (int i = 0; i < 32; ++i) { const int kk = 2 * i + (lane >> 5); scr[kk * 33 + (lane & 31)] = W[(size_t)(k0 + kk) * N + n0 + (lane & 31)]; }
    asm volatile("s_waitcnt lgkmcnt(0)" ::: "memory");
    const int c = lane & 7;
#pragma unroll
    for (int j = 0; j < 4; ++j) { const int n = (lane >> 3) + 8 * j; const float* s = scr + (8 * c) * 33 + n;
        u32x4 o; o.x = pk2(s[0 * 33], s[1 * 33]); o.y = pk2(s[2 * 33], s[3 * 33]); o.z = pk2(s[4 * 33], s[5 * 33]); o.w = pk2(s[6 * 33], s[7 * 33]);
        *(u32x4*)(WT + (size_t)(row_off + n0 + n) * K + k0 + 8 * c) = o; }
    asm volatile("s_waitcnt lgkmcnt(0)" ::: "memory");
}
__device__ __forceinline__ void conv_mat(const Fr& F, const float* W, int K, int N, bf16* WT, int row_off) {
    float* scr = (float*)(F.lds + F.wave * 16384);
    const int nitems = (K / 64) * (N / 32);
    for (int it = F.gw; it < nitems; it += GRID * NWAVES) transpose_item(W, K, N, WT, row_off, scr, it, F.lane);
}
__device__ __forceinline__ void conv_rwkv(const Fr& F, int j) {
    const float* rkvg = F.a->in[8] + (size_t)j * 4 * D * D;
    conv_mat(F, rkvg, D, D, F.WT(), 0); conv_mat(F, rkvg + (size_t)D * D, D, D, F.WT(), 1024);
    conv_mat(F, rkvg + (size_t)2 * D * D, D, D, F.WT(), 2560); conv_mat(F, rkvg + (size_t)3 * D * D, D, D, F.WT(), 3584);
    for (int s = 0; s < 2; ++s) {
        conv_mat(F, F.a->in[10] + (size_t)(j * 2 + s) * D * 64, D, 64, F.WT(), 2048 + 64 * s);
        conv_mat(F, F.a->in[13] + (size_t)(j * 2 + s) * D * 64, D, 64, F.WT(), 2304 + 64 * s);
        conv_mat(F, F.a->in[11] + (size_t)(j * 2 + s) * 64 * D, 64, D, (bf16*)(F.ws + OFF_L2T) + (size_t)s * D * 64, 0);
        conv_mat(F, F.a->in[14] + (size_t)(j * 2 + s) * 64 * D, 64, D, (bf16*)(F.ws + OFF_L2T) + (size_t)(2 + s) * D * 64, 0);
    }
    conv_mat(F, F.a->in[20] + (size_t)j * D * D, D, D, F.WT(), 4608);
}

__device__ __forceinline__ void phase_mod(const Fr& F) {
    float* sc = (float*)F.lds;
    float* red = sc + 5120;
    for (int i = F.tid; i < 5120; i += NTHR) { const int j = i >> 10, k = i & 1023; const float v = j < 4 ? F.a->in[1][j * D + k] : F.a->in[3][k]; sc[i] = silu(v); }
    __syncthreads();
    for (int task = blockIdx.x; task < 192; task += gridDim.x) {
        const int l = task / 48, n0 = (task - l * 48) * 64;
        const float* wm = F.a->in[5] + (size_t)l * D * 3072 + n0 + F.lane;
        float acc[5] = {0.f, 0.f, 0.f, 0.f, 0.f};
#pragma unroll 8
        for (int kk = 0; kk < 128; ++kk) { const int k = F.wave * 128 + kk; const float w = wm[(size_t)k * 3072];
#pragma unroll
            for (int j = 0; j < 5; ++j) acc[j] += sc[j * 1024 + k] * w; }
#pragma unroll
        for (int j = 0; j < 5; ++j) red[(F.wave * 5 + j) * 64 + F.lane] = acc[j];
        __syncthreads();
        if (F.tid < 320) { const int j = F.tid >> 6, ln = F.tid & 63; float s = F.a->in[6][l * 3072 + n0 + ln];
            for (int w = 0; w < 8; ++w) s += red[(w * 5 + j) * 64 + ln];
            F.mod(l)[j * 3072 + n0 + ln] = s; }
        __syncthreads();
    }
}

__device__ __forceinline__ void load_h(const Fr& F, int l, int m, bool valid, f32x4 (&h)[4]) {
    if (!valid) { for (int j = 0; j < 4; ++j) h[j] = (f32x4){0.f, 0.f, 0.f, 0.f}; return; }
    const f32x4* xr = (const f32x4*)xrow(F, l, m) + F.lane;
    float ss = 0.f;
#pragma unroll
    for (int j = 0; j < 4; ++j) { h[j] = xr[64 * j]; ss += (h[j].x * h[j].x + h[j].y * h[j].y) + (h[j].z * h[j].z + h[j].w * h[j].w); }
    const float rstd = 1.f / sqrtf(wave_sum(ss) * (1.f / D) + 1e-6f);
    const int b = m / TB, t = m - b * TB; const float* md = F.mod(l) + (t < CTXL ? 4 : b) * 3072;
    const f32x4* g = (const f32x4*)(F.a->in[4] + l * D) + F.lane; const f32x4* sh = (const f32x4*)md + F.lane; const f32x4* scl = (const f32x4*)(md + 1024) + F.lane;
#pragma unroll
    for (int j = 0; j < 4; ++j) h[j] = (h[j] * rstd) * g[64 * j] * (scl[64 * j] + 1.f) + sh[64 * j];
}
__device__ __forceinline__ void store_row_bf16(bf16* orow, int lane, const f32x4 (&v)[4]) {
    u32x2* o = (u32x2*)orow + lane;
#pragma unroll
    for (int j = 0; j < 4; ++j) { u32x2 w; w.x = pk2(v[j].x, v[j].y); w.y = pk2(v[j].z, v[j].w); o[64 * j] = w; }
}
__device__ __forceinline__ void phase_norm_plain(const Fr& F, int l) {
    for (int m = F.gw; m < NT; m += GRID * NWAVES) { f32x4 h[4]; load_h(F, l, m, true, h); store_row_bf16(F.R(0) + (size_t)m * D, F.lane, h); }
}
__device__ __forceinline__ void phase_norm_mix(const Fr& F, int l, int jr, int nmix, int n0, int n1, int n2, int n3) {
    const int nidx[4] = {n0, n1, n2, n3};
    for (int run = F.gw; run < NT / 8; run += GRID * NWAVES) {
        const int m0 = run * 8, b = m0 / TB, t0 = m0 - b * TB, seg_lo = t0 < CTXL ? 0 : CTXL, seg_hi = t0 < CTXL ? CTXL : TB;
        f32x4 hp[4], hc[4], hn[4];
        load_h(F, l, m0 - 1, t0 > seg_lo, hp); load_h(F, l, m0, true, hc);
        for (int i = 0; i < 8; ++i) {
            load_h(F, l, m0 + i + 1, t0 + i + 1 < seg_hi, hn);
#pragma unroll
            for (int q = 0; q < 4; ++q) if (q < nmix) {
                const f32x4* mu = (const f32x4*)(F.a->in[7] + (size_t)(jr * 6 + nidx[q]) * D) + F.lane; f32x4 o[4];
#pragma unroll
                for (int j = 0; j < 4; ++j) o[j] = hc[j] + ((hp[j] + hn[j]) * 0.5f - hc[j]) * mu[64 * j];
                store_row_bf16(F.R(q) + (size_t)(m0 + i) * D, F.lane, o);
            }
#pragma unroll
            for (int j = 0; j < 4; ++j) { hp[j] = hc[j]; hc[j] = hn[j]; }
        }
    }
}

__device__ __forceinline__ void phase_rwkv_scan(const Fr& F, int jr) {
    float* Wv = (float*)F.lds; float* KK = Wv + 4096; float* Bv = KK + 4096; float* KD = Bv + 4096; float* Rr = KD + 4096; float* Av = Rr + 4096;
    float* Vv = Av + 4096; float* Yv = Vv + 2048;
    const bf16* Rb = F.R(4); const bf16* Kb = F.R(5); const bf16* Vb = F.R(2); const bf16* LM = F.R(6);
    const bf16* L2T = (const bf16*)(F.ws + OFF_L2T);
    const int lane = F.lane, wave = F.wave, tid = F.tid;
    for (int task = blockIdx.x; task < 256; task += gridDim.x) {
        const int half = task & 1, h = (task >> 1) & 15, b = (task >> 5) & 3, s = task >> 7;
        bf16* Yb = F.R(s);
        const float* w0 = F.a->in[9] + (size_t)(jr * 2 + s) * D + h * 64; const float* a0 = F.a->in[12] + (size_t)(jr * 2 + s) * D + h * 64;
        const float* kkw = F.a->in[15] + (size_t)jr * D + h * 64; const float* kaw = F.a->in[16] + (size_t)jr * D + h * 64;
        float S0 = 0.f, S1 = 0.f, S2 = 0.f, S3 = 0.f;
        const int ks = 4 * (lane & 15), rloc = 4 * wave + (lane >> 4);
        for (int chunk = 0; chunk < TB / 64; ++chunk) {
            {
                const int pt = wave & 3, ht0 = (wave >> 2) * 2;
                const int p = pt * 16 + (lane & 15), tok = tokof(s, chunk * 64 + p); const size_t row = (size_t)b * TB + tok;
                bf16x8 Aw[2], Aa[2];
#pragma unroll
                for (int kst = 0; kst < 2; ++kst) { Aw[kst] = *(const bf16x8*)(LM + row * 256 + 64 * s + 32 * kst + 8 * (lane >> 4)); Aa[kst] = *(const bf16x8*)(LM + row * 256 + 128 + 64 * s + 32 * kst + 8 * (lane >> 4)); }
#pragma unroll
                for (int hh = 0; hh < 2; ++hh) {
                    const int hk = (ht0 + hh) * 16 + (lane & 15), e = h * 64 + hk;
                    f32x4 cw = {0.f, 0.f, 0.f, 0.f}, ca = {0.f, 0.f, 0.f, 0.f};
#pragma unroll
                    for (int kst = 0; kst < 2; ++kst) {
                        const bf16x8 Bw = *(const bf16x8*)(L2T + ((size_t)s * D + e) * 64 + 32 * kst + 8 * (lane >> 4));
                        const bf16x8 Ba = *(const bf16x8*)(L2T + ((size_t)(2 + s) * D + e) * 64 + 32 * kst + 8 * (lane >> 4));
                        cw = __builtin_amdgcn_mfma_f32_16x16x32_bf16(Aw[kst], Bw, cw, 0, 0, 0);
                        ca = __builtin_amdgcn_mfma_f32_16x16x32_bf16(Aa[kst], Ba, ca, 0, 0, 0);
                    }
                    const float w0v = w0[hk], a0v = a0[hk];
#pragma unroll
                    for (int reg = 0; reg < 4; ++reg) {
                        const int pp = pt * 16 + (lane >> 4) * 4 + reg;
                        const float z = -(w0v + cw[reg]);
                        const float sp = fmaxf(z, 0.f) + log1pf(__expf(-fabsf(z)));
                        Wv[pp * 64 + hk] = __expf(-__expf(-sp - 0.5f));
                        Av[pp * 64 + hk] = sigm(a0v + ca[reg]);
                    }
                }
            }
            __syncthreads();
            {
                const int p = tid >> 3, j8 = tid & 7, tok = tokof(s, chunk * 64 + p); const size_t row = (size_t)b * TB + tok;
                const int hk0 = 8 * j8;
                const u32x4 kw = *(const u32x4*)(Kb + row * D + h * 64 + hk0), rw = *(const u32x4*)(Rb + row * D + h * 64 + hk0);
                float kr[8] = {lo_bf(kw.x), hi_bf(kw.x), lo_bf(kw.y), hi_bf(kw.y), lo_bf(kw.z), hi_bf(kw.z), lo_bf(kw.w), hi_bf(kw.w)};
                float rr[8] = {lo_bf(rw.x), hi_bf(rw.x), lo_bf(rw.y), hi_bf(rw.y), lo_bf(rw.z), hi_bf(rw.z), lo_bf(rw.w), hi_bf(rw.w)};
                float kq[8]; float ss = 0.f;
#pragma unroll
                for (int i = 0; i < 8; ++i) { kq[i] = kr[i] * kkw[hk0 + i]; ss += kq[i] * kq[i]; }
                ss += __shfl_xor(ss, 1); ss += __shfl_xor(ss, 2); ss += __shfl_xor(ss, 4);
                const float inv = 1.f / fmaxf(sqrtf(ss), 1e-12f);
#pragma unroll
                for (int i = 0; i < 8; ++i) { const int o = p * 64 + hk0 + i; const float a = Av[o], kkv = kq[i] * inv;
                    KK[o] = kkv; Bv[o] = kkv * a; KD[o] = kr[i] * (1.f + (a - 1.f) * kaw[hk0 + i]); Rr[o] = rr[i]; }
                const u32x2 vw = *(const u32x2*)(Vb + row * D + h * 64 + 32 * half + 4 * j8);
                Vv[p * 32 + 4 * j8 + 0] = lo_bf(vw.x); Vv[p * 32 + 4 * j8 + 1] = hi_bf(vw.x); Vv[p * 32 + 4 * j8 + 2] = lo_bf(vw.y); Vv[p * 32 + 4 * j8 + 3] = hi_bf(vw.y);
            }
            __syncthreads();
#pragma unroll 2
            for (int p = 0; p < 64; ++p) {
                const f32x4 w4 = *(const f32x4*)(Wv + p * 64 + ks), k4 = *(const f32x4*)(KK + p * 64 + ks), b4 = *(const f32x4*)(Bv + p * 64 + ks),
                            d4 = *(const f32x4*)(KD + p * 64 + ks), r4 = *(const f32x4*)(Rr + p * 64 + ks);
                const float vv = Vv[p * 32 + rloc];
                float sa = (S0 * k4.x + S1 * k4.y) + (S2 * k4.z + S3 * k4.w);
                sa = allred16(sa);
                S0 = S0 * w4.x + (vv * d4.x - sa * b4.x); S1 = S1 * w4.y + (vv * d4.y - sa * b4.y);
                S2 = S2 * w4.z + (vv * d4.z - sa * b4.z); S3 = S3 * w4.w + (vv * d4.w - sa * b4.w);
                float y = (S0 * r4.x + S1 * r4.y) + (S2 * r4.z + S3 * r4.w);
                y = allred16(y);
                if ((lane & 15) == 0) Yv[p * 32 + rloc] = y;
            }
            __syncthreads();
            {
                const int p = tid >> 3, j8 = tid & 7, tok = tokof(s, chunk * 64 + p); const size_t row = (size_t)b * TB + tok;
                u32x2 w; w.x = pk2(Yv[p * 32 + 4 * j8], Yv[p * 32 + 4 * j8 + 1]); w.y = pk2(Yv[p * 32 + 4 * j8 + 2], Yv[p * 32 + 4 * j8 + 3]);
                *(u32x2*)(Yb + row * D + h * 64 + 32 * half + 4 * j8) = w;
            }
        }
        __syncthreads();
    }
}

__device__ __forceinline__ void phase_rwkv_post(const Fr& F, int jr) {
    const float* rk = F.a->in[17] + (size_t)jr * D; const float* lnw = F.a->in[18] + (size_t)jr * D; const float* lnb = F.a->in[19] + (size_t)jr * D;
    for (int m = F.gw; m < NT; m += GRID * NWAVES) {
        const size_t base = (size_t)m * D;
        u32x2 ow[4];
#pragma unroll
        for (int j = 0; j < 4; ++j) {
            const int c = 256 * j + 4 * F.lane;
            const u32x2 y0 = *(const u32x2*)(F.R(0) + base + c), y1 = *(const u32x2*)(F.R(1) + base + c), rw = *(const u32x2*)(F.R(4) + base + c),
                        kw = *(const u32x2*)(F.R(5) + base + c), vw = *(const u32x2*)(F.R(2) + base + c), gw = *(const u32x2*)(F.R(3) + base + c);
            float y[4] = {lo_bf(y0.x) + lo_bf(y1.x), hi_bf(y0.x) + hi_bf(y1.x), lo_bf(y0.y) + lo_bf(y1.y), hi_bf(y0.y) + hi_bf(y1.y)};
            const float r[4] = {lo_bf(rw.x), hi_bf(rw.x), lo_bf(rw.y), hi_bf(rw.y)}, k[4] = {lo_bf(kw.x), hi_bf(kw.x), lo_bf(kw.y), hi_bf(kw.y)};
            const float v[4] = {lo_bf(vw.x), hi_bf(vw.x), lo_bf(vw.y), hi_bf(vw.y)}, g[4] = {lo_bf(gw.x), hi_bf(gw.x), lo_bf(gw.y), hi_bf(gw.y)};
            const f32x4 rkv = *(const f32x4*)(rk + c), lw = *(const f32x4*)(lnw + c), lb = *(const f32x4*)(lnb + c);
            const float mean = allred16((y[0] + y[1]) + (y[2] + y[3])) * (1.f / 64.f);
            float q = 0.f, bsum = 0.f;
#pragma unroll
            for (int i = 0; i < 4; ++i) { y[i] -= mean; q += y[i] * y[i]; bsum += r[i] * k[i] * rkv[i]; }
            const float rstd = 1.f / sqrtf(allred16(q) * (1.f / 64.f) + 64e-5f);
            bsum = allred16(bsum);
            float o[4];
#pragma unroll
            for (int i = 0; i < 4; ++i) o[i] = (y[i] * rstd * lw[i] + lb[i] + bsum * v[i]) * silu(g[i]);
            ow[j].x = pk2(o[0], o[1]); ow[j].y = pk2(o[2], o[3]);
        }
#pragma unroll
        for (int j = 0; j < 4; ++j) *(u32x2*)(F.R(0) + base + 256 * j + 4 * F.lane) = ow[j];
    }
}

__device__ __forceinline__ void phase_na_qknorm(const Fr& F) {
    const float* qg = F.a->in[22]; const float* kg = F.a->in[23];
    const int d0 = 4 * (F.lane & 15);
    for (int m = F.gw; m < 2 * NT; m += GRID * NWAVES) {
        const int isk = m >= NT; bf16* p = F.R(1 + isk) + (size_t)(m - isk * NT) * D; const float* g = isk ? kg : qg; const float sc = isk ? 1.f : 0.125f;
#pragma unroll
        for (int j = 0; j < 4; ++j) {
            u32x2* pp = (u32x2*)(p + 256 * j + 4 * F.lane); const u32x2 w = *pp;
            float x[4] = {lo_bf(w.x), hi_bf(w.x), lo_bf(w.y), hi_bf(w.y)};
            const float ss = allred16((x[0] * x[0] + x[1] * x[1]) + (x[2] * x[2] + x[3] * x[3]));
            const float rstd = sc / sqrtf(ss * (1.f / 64.f) + 1e-6f);
            u32x2 o; o.x = pk2(x[0] * rstd * g[d0], x[1] * rstd * g[d0 + 1]); o.y = pk2(x[2] * rstd * g[d0 + 2], x[3] * rstd * g[d0 + 3]);
            *pp = o;
        }
    }
}
__device__ __forceinline__ void phase_na_attn(const Fr& F) {
    constexpr int PST = 40;
    bf16* Pl = (bf16*)(F.lds + F.wave * 4096); float* rpbT = (float*)(F.lds + F.wave * 4096 + 1536);
    const bf16* Qn = F.R(1); const bf16* Kn = F.R(2); const bf16* VT = F.R(3); const bf16* Z = F.R(4); bf16* Og = F.R(1);
    const int lane = F.lane, l15 = lane & 15, lq = lane >> 4, gw = F.gw;
    const int h_fix = (gw >> 7) & 15;
    for (int i = lane; i < 465; i += 64) rpbT[i] = F.a->in[24][h_fix * 465 + i];
    asm volatile("s_waitcnt lgkmcnt(0)" ::: "memory");
    for (int it = 0; it < 9; ++it) {
        int b, h, qrow0, ntile_nb, gi = 0, q0 = 0, lo = 0, r0 = 0;
        if (it < 8) { b = it >> 1; h = h_fix; gi = ((it & 1) << 5) | ((gw >> 2) & 31); const int qt = gw & 3; q0 = 16 * qt; lo = qt == 0 ? 0 : (qt == 1 ? 8 : (qt == 2 ? 24 : 32));
            r0 = min(max(gi - 4, 0), 56); qrow0 = b * TB + CTXL + gi * 64 + q0; ntile_nb = 8; }
        else { if (gw >= 1024) break; b = gw >> 8; h = (gw >> 4) & 15; qrow0 = b * TB + 16 * (gw & 15); ntile_nb = 0; }
        bf16x8 Qf[2];
#pragma unroll
        for (int ds = 0; ds < 2; ++ds) Qf[ds] = *(const bf16x8*)(Qn + (size_t)(qrow0 + l15) * D + h * 64 + 32 * ds + 8 * lq);
        f32x4 O[4]; float lsum[4] = {0.f, 0.f, 0.f, 0.f};
#pragma unroll
        for (int dt = 0; dt < 4; ++dt) O[dt] = (f32x4){0.f, 0.f, 0.f, 0.f};
        const int ntile = ntile_nb + 8;
        for (int tl = 0; tl < ntile; ++tl) {
            const bool nb = tl < ntile_nb;
            const int tloc = nb ? (CTXL + (r0 + tl) * 64 + lo) : 32 * (tl - ntile_nb);
            const size_t krow = (size_t)b * TB + tloc;
            f32x4 Sx[2];
#pragma unroll
            for (int st = 0; st < 2; ++st) {
                Sx[st] = (f32x4){0.f, 0.f, 0.f, 0.f};
#pragma unroll
                for (int ds = 0; ds < 2; ++ds) { const bf16x8 Kf = *(const bf16x8*)(Kn + (krow + 16 * st + l15) * D + h * 64 + 32 * ds + 8 * lq);
                    Sx[st] = __builtin_amdgcn_mfma_f32_16x16x32_bf16(Qf[ds], Kf, Sx[st], 0, 0, 0); }
            }
            asm volatile("s_waitcnt lgkmcnt(0)" ::: "memory");
#pragma unroll
            for (int st = 0; st < 2; ++st)
#pragma unroll
                for (int reg = 0; reg < 4; ++reg) {
                    float pv;
                    if (nb) {
                        const int c = lo + 16 * st + l15, qc = q0 + 4 * lq + reg, cs = min(max(qc - 8, 0), 48);
                        const bool valid = (c >= cs) && (c < cs + 16);
                        const int bidx = (r0 + tl - gi + 7) * 31 + min(max(c - qc + 15, 0), 30);
                        pv = valid ? __expf(Sx[st][reg] + rpbT[bidx]) : 0.f;
                    } else pv = __expf(Sx[st][reg]);
                    lsum[reg] += pv;
                    Pl[(4 * lq + reg) * PST + 16 * st + l15] = (bf16)f2bf(pv);
                }
            asm volatile("s_waitcnt lgkmcnt(0)" ::: "memory");
            const bf16x8 Pf = *(const bf16x8*)(Pl + l15 * PST + 8 * lq);
#pragma unroll
            for (int dt = 0; dt < 4; ++dt) { const bf16x8 Vf = *(const bf16x8*)(VT + ((size_t)(b * 16 + h) * 64 + 16 * dt + l15) * TB + tloc + 8 * lq);
                O[dt] = __builtin_amdgcn_mfma_f32_16x16x32_bf16(Pf, Vf, O[dt], 0, 0, 0); }
        }
#pragma unroll
        for (int reg = 0; reg < 4; ++reg) {
            const float inv = 1.f / allred16(lsum[reg]); const size_t row = (size_t)(qrow0 + 4 * lq + reg) * D + h * 64;
#pragma unroll
            for (int dt = 0; dt < 4; ++dt) { const int d = 16 * dt + l15; Og[row + d] = (bf16)f2bf(O[dt][reg] * inv * silu(bf2f(Z[row + d]))); }
        }
    }
}

__device__ __forceinline__ void phase_s5_params(const Fr& F) {
    const int idx = blockIdx.x * NTHR + F.tid; if (idx >= 8192) return;
    const int p = idx & 63, g = (idx >> 6) & 63, s = idx >> 12;
    const float lr = F.a->in[27][idx], li = F.a->in[28][idx], step = expf(F.a->in[29][s * 64 + g]);
    const float mag = expf(lr * step), ar = mag * cosf(li * step), ai = mag * sinf(li * step), den = lr * lr + li * li;
    const float qr = ((ar - 1.f) * lr + ai * li) / den, qi = (ai * lr - (ar - 1.f) * li) / den;
    float pr = ar, pi = ai;
    for (int i = 0; i < 6; ++i) { const float nr = pr * pr - pi * pi, ni = 2.f * pr * pi; pr = nr; pi = ni; }
    float* A = (float*)(F.ws + OFF_S5A) + idx * 4; A[0] = ar; A[1] = ai; A[2] = pr; A[3] = pi;
    float* BB = (float*)(F.ws + OFF_BB) + (size_t)idx * 32;
    const float* br = F.a->in[30] + ((size_t)g * 64 + p) * 16; const float* bi = F.a->in[31] + ((size_t)g * 64 + p) * 16;
    for (int c = 0; c < 16; ++c) { BB[c] = qr * br[c] - qi * bi[c]; BB[16 + c] = qr * bi[c] + qi * br[c]; }
}
template <bool FINAL> __device__ __forceinline__ void phase_s5_scan(const Fr& F) {
    const float* U = (const float*)F.R(1); float* E = (float*)F.R(6);
    float* X = (float*)(F.lds + F.wave * 16384);
    const int lane = F.lane;
    for (int task = F.gw; task < 2 * NB * 64 * 68; task += GRID * NWAVES) {
        const int chunk = task % 68, sbg = task / 68, g = sbg & 63, b = (sbg >> 6) & 3, s = sbg >> 8;
        const int pidx = (s * 64 + g) * 64 + lane;
        const f32x4 av = *(const f32x4*)((const float*)(F.ws + OFF_S5A) + pidx * 4);
        const float ar = av.x, ai = av.y;
        float bbr[16], bbi[16];
        { const f32x4* bp = (const f32x4*)((const float*)(F.ws + OFF_BB) + (size_t)pidx * 32);
#pragma unroll
          for (int i = 0; i < 4; ++i) { const f32x4 t = bp[i], t2 = bp[4 + i]; bbr[4 * i] = t.x; bbr[4 * i + 1] = t.y; bbr[4 * i + 2] = t.z; bbr[4 * i + 3] = t.w; bbi[4 * i] = t2.x; bbi[4 * i + 1] = t2.y; bbi[4 * i + 2] = t2.z; bbi[4 * i + 3] = t2.w; } }
        float xr = 0.f, xi = 0.f;
        float cm[32];
        bf16* Yb = F.R(4 + s);
        if (FINAL) {
            const float* e = E + ((size_t)task * 64 + lane) * 2; xr = e[0]; xi = e[1];
            const float* cr = F.a->in[32] + (size_t)g * 1024; const float* ci = F.a->in[33] + (size_t)g * 1024;
#pragma unroll
            for (int kk = 0; kk < 32; ++kk) { const int k = 4 * kk + (lane >> 4), c = lane & 15; cm[kk] = k < 64 ? cr[c * 64 + k] : -ci[c * 64 + (k - 64)]; }
        }
        for (int sub = 0; sub < 4; ++sub) {
            for (int jj = 0; jj < 16; ++jj) {
                const int tok = tokof(s, chunk * 64 + sub * 16 + jj);
                const f32x4* up = (const f32x4*)(U + ((size_t)b * TB + tok) * D + g * 16);
                const f32x4 u0 = up[0], u1 = up[1], u2 = up[2], u3 = up[3];
                const float uu[16] = {u0.x, u0.y, u0.z, u0.w, u1.x, u1.y, u1.z, u1.w, u2.x, u2.y, u2.z, u2.w, u3.x, u3.y, u3.z, u3.w};
                float br_ = 0.f, bi_ = 0.f;
#pragma unroll
                for (int c = 0; c < 16; ++c) { br_ += bbr[c] * uu[c]; bi_ += bbi[c] * uu[c]; }
                const float nr = ar * xr - ai * xi + br_, ni = ar * xi + ai * xr + bi_; xr = nr; xi = ni;
                if (FINAL) { X[jj * 129 + lane] = xr; X[jj * 129 + 64 + lane] = xi; }
            }
            if (FINAL) {
                asm volatile("s_waitcnt lgkmcnt(0)" ::: "memory");
                f32x4 acc = {0.f, 0.f, 0.f, 0.f};
#pragma unroll
                for (int kk = 0; kk < 32; ++kk) acc = __builtin_amdgcn_mfma_f32_16x16x4f32(X[(lane & 15) * 129 + 4 * kk + (lane >> 4)], cm[kk], acc, 0, 0, 0);
                asm volatile("s_waitcnt lgkmcnt(0)" ::: "memory");
#pragma unroll
                for (int reg = 0; reg < 4; ++reg) { const int tok = tokof(s, chunk * 64 + sub * 16 + 4 * (lane >> 4) + reg);
                    Yb[((size_t)b * TB + tok) * D + g * 16 + (lane & 15)] = (bf16)f2bf(acc[reg]); }
            }
        }
        if (!FINAL) { float* e = E + ((size_t)task * 64 + lane) * 2; e[0] = xr; e[1] = xi; }
    }
}
__device__ __forceinline__ void phase_s5_carry(const Fr& F) {
    const int idx = blockIdx.x * NTHR + F.tid; if (idx >= 2 * NB * 64 * 64) return;
    const int p = idx & 63, sbg = idx >> 6, g = sbg & 63, s = sbg >> 8;
    const f32x4 av = *(const f32x4*)((const float*)(F.ws + OFF_S5A) + ((s * 64 + g) * 64 + p) * 4);
    float* E = (float*)F.R(6) + ((size_t)sbg * 68 * 64 + p) * 2;
    float cr = 0.f, ci = 0.f;
    for (int c = 0; c < 68; ++c) { const float er = E[(size_t)c * 128], ei = E[(size_t)c * 128 + 1]; E[(size_t)c * 128] = cr; E[(size_t)c * 128 + 1] = ci;
        const float nr = av.z * cr - av.w * ci + er, ni = av.z * ci + av.w * cr + ei; cr = nr; ci = ni; }
}
__device__ __forceinline__ void phase_s5_combine(const Fr& F) {
    const float* U = (const float*)F.R(1); const float* dsk = F.a->in[34];
    for (size_t i = (size_t)blockIdx.x * NTHR + F.tid; i < (size_t)NT * D / 4; i += (size_t)GRID * NTHR) {
        const size_t e = i * 4; const int c = (int)(e & 1023);
        const u32x2 y0 = *(const u32x2*)(F.R(4) + e), y1 = *(const u32x2*)(F.R(5) + e); const f32x4 u = *(const f32x4*)(U + e), d = *(const f32x4*)(dsk + c);
        float y[4] = {lo_bf(y0.x) + lo_bf(y1.x) + d.x * u.x, hi_bf(y0.x) + hi_bf(y1.x) + d.y * u.y, lo_bf(y0.y) + lo_bf(y1.y) + d.z * u.z, hi_bf(y0.y) + hi_bf(y1.y) + d.w * u.w};
#pragma unroll
        for (int k = 0; k < 4; ++k) { const float x = y[k]; y[k] = 0.5f * x * (1.f + tanhf(0.7978845608f * (x + 0.044715f * x * x * x))); }
        u32x2 o; o.x = pk2(y[0], y[1]); o.y = pk2(y[2], y[3]); *(u32x2*)(F.R(0) + e) = o;
    }
}

constexpr int NPHASE = 28;
#define PH(k) if (args.ph_lo <= (k) && (k) < args.ph_hi)
#define SEAM(k) if (args.ph_lo <= (k) && (k) + 1 < args.ph_hi) grid.sync()
#define RWKV_LAYER(P0, L, JR, XO, CO) \
    PH(P0 + 0) { if (L == 3) conv_rwkv(F, 1); phase_norm_mix(F, L, JR, 4, 0, 1, 4, 5); } SEAM(P0 + 0); \
    PH(P0 + 1) { run_gemm(F, F.R(0), F.WT(), D, 680, 1, 0, FRkv{F.R(4), F.R(5), F.R(6)}); } SEAM(P0 + 1); \
    PH(P0 + 2) { phase_norm_mix(F, L, JR, 2, 2, 3, 0, 0); } SEAM(P0 + 2); \
    PH(P0 + 3) { run_gemm(F, F.R(0), F.WT() + (size_t)2560 * D, D, 544, 2, 0, FRkv{F.R(2), F.R(3), nullptr}); } SEAM(P0 + 3); \
    PH(P0 + 4) { phase_rwkv_scan(F, JR); } SEAM(P0 + 4); \
    PH(P0 + 5) { phase_rwkv_post(F, JR); } SEAM(P0 + 5); \
    PH(P0 + 6) { run_gemm(F, F.R(0), F.WT() + (size_t)4608 * D, D, 272, 0, 4, FResid{XO, CO, args.out, F.ctxbuf(), F.mod(L)}); } SEAM(P0 + 6);
__global__ void __launch_bounds__(NTHR) fwd_kernel(Args args) {
    extern __shared__ __attribute__((aligned(16))) unsigned char lds[];
    cg::grid_group grid = cg::this_grid();
    Fr F; F.a = &args; F.lds = lds; F.ws = args.ws; F.tid = threadIdx.x; F.lane = F.tid & 63; F.wave = __builtin_amdgcn_readfirstlane(F.tid >> 6); F.gw = blockIdx.x * NWAVES + F.wave;
    PH(0) { phase_mod(F); conv_rwkv(F, 0); phase_s5_params(F); } SEAM(0);
    RWKV_LAYER(1, 0, 0, args.in[0], args.in[2])
    PH(8) { conv_mat(F, args.in[21], D, 4 * D, F.WT(), 0); conv_mat(F, args.in[25], D, D, F.WT(), 4096); phase_norm_plain(F, 1); } SEAM(8);
    PH(9) { run_gemm(F, F.R(0), F.WT(), D, 1088, 0, 16, FNaIn{F.R(1), F.R(2), F.R(3), F.R(4)}); } SEAM(9);
    PH(10) { phase_na_qknorm(F); } SEAM(10);
    PH(11) { phase_na_attn(F); } SEAM(11);
    PH(12) { run_gemm(F, F.R(1), F.WT() + (size_t)4096 * D, D, 272, 0, 4, FResid{args.out, F.ctxbuf(), args.out, F.ctxbuf(), F.mod(1)}); } SEAM(12);
    PH(13) { conv_mat(F, args.in[26], D, 2 * D, F.WT(), 0); conv_mat(F, args.in[35], D, D, F.WT(), 2048); conv_mat(F, args.in[37], D, D, F.WT(), 3072); phase_norm_plain(F, 2); } SEAM(13);
    PH(14) { run_gemm(F, F.R(0), F.WT(), D, 544, 0, 8, FS5In{(float*)F.R(1), F.R(3)}); } SEAM(14);
    PH(15) { phase_s5_scan<false>(F); } SEAM(15);
    PH(16) { phase_s5_carry(F); } SEAM(16);
    PH(17) { phase_s5_scan<true>(F); } SEAM(17);
    PH(18) { phase_s5_combine(F); } SEAM(18);
    PH(19) { run_gemm(F, F.R(0), F.WT() + (size_t)2048 * D, D, 272, 0, 4, FGlu{F.R(0), F.R(3), args.in[36], F.R(4)}); } SEAM(19);
    PH(20) { run_gemm(F, F.R(4), F.WT() + (size_t)3072 * D, D, 272, 0, 4, FResid{args.out, F.ctxbuf(), args.out, F.ctxbuf(), F.mod(2)}); } SEAM(20);
    RWKV_LAYER(21, 3, 1, args.out, F.ctxbuf())
}

#ifndef MULTI_LAUNCH
#define MULTI_LAUNCH 1
#endif
extern "C" void kernel_launch(void* const* d_in, const int* in_sizes, int n_in, void* d_out, int out_size, void* d_ws, size_t ws_size, hipStream_t stream) {
    static int ready = 0;
    if (ready == 0) {
        ready = -1;
        if (n_in != 38 || ws_size < WS_NEED || out_size != NB * SEQ * D) { fprintf(stderr, "kernel_launch: unexpected problem (n_in %d ws %zu out %d)\n", n_in, ws_size, out_size); return; }
        if (hipFuncSetAttribute((const void*)fwd_kernel, hipFuncAttributeMaxDynamicSharedMemorySize, LDS_BYTES) != hipSuccess) { fprintf(stderr, "kernel_launch: hipFuncSetAttribute failed\n"); return; }
        int dev = 0, cus = 0, per_cu = 0;
        hipGetDevice(&dev); hipDeviceGetAttribute(&cus, hipDeviceAttributeMultiprocessorCount, dev);
        hipOccupancyMaxActiveBlocksPerMultiprocessor(&per_cu, (const void*)fwd_kernel, NTHR, LDS_BYTES);
        if (cus * per_cu < GRID) { fprintf(stderr, "kernel_launch: grid of %d not resident (%d CUs x %d)\n", GRID, cus, per_cu); return; }
        ready = 1;
    }
    if (ready < 0) return;
    Args a{};
    for (int i = 0; i < 38; ++i) a.in[i] = (const float*)d_in[i];
    a.out = (float*)d_out; a.ws = (unsigned char*)d_ws;
#if MULTI_LAUNCH
    for (int ph = 0; ph < NPHASE; ++ph) { a.ph_lo = ph; a.ph_hi = ph + 1; hipLaunchKernelGGL(fwd_kernel, dim3(GRID), dim3(NTHR), LDS_BYTES, stream, a); }
#else
    a.ph_lo = 0; a.ph_hi = NPHASE;
    void* kargs[] = {&a};
    hipError_t e = hipLaunchCooperativeKernel((const void*)fwd_kernel, dim3(GRID), dim3(NTHR), kargs, LDS_BYTES, stream);
    if (e != hipSuccess) fprintf(stderr, "cooperative launch failed: %s\n", hipGetErrorString(e));
#endif
}
```

```cpp
#include <hip/hip_runtime.h>
#include <hip/hip_cooperative_groups.h>
#include <cstdio>
#include <cstdint>
namespace cg = cooperative_groups;

namespace pg8 {
#define PG8_LAS __attribute__((address_space(3)))
typedef unsigned short bf16_t;
typedef short bf16x8 __attribute__((ext_vector_type(8)));
typedef float f32x4 __attribute__((ext_vector_type(4)));
typedef unsigned u32x4 __attribute__((ext_vector_type(4)));
constexpr int BM = 256, BK = 64, HALF = 128, HTB = HALF * BK * 2  , STAGE_BYTES = 8 * HTB, NXCD = 8, WGM = 8;

__host__ __device__ __forceinline__ int lds_byte(int r, int c) { const int st = (r >> 4) * 2 + (c >> 5), rr = r & 15, cc = c & 31, ob = rr * 64 + cc * 2; return st * 1024 + (ob ^ (((ob >> 9) & 1) << 5)); }
__host__ __device__ __forceinline__ void stage_rc(int b, int& R, int& C) { const int st = b / 1024, sb = b % 1024, swz = sb ^ (((sb >> 9) & 1) << 5); R = (st >> 1) * 16 + swz / 64; C = (st & 1) * 32 + (swz % 64) / 2; }
__host__ __device__ __forceinline__ int perm32(int rho) { const int n = rho >> 4, i = rho & 15; return 8 * (i >> 2) + 4 * n + (i & 3); }

struct Unit { int pm, pn; };
struct Gemm { const bf16_t* A; const bf16_t* Bt; int M, N, K; };

struct ListOrder {
    int n, G, c, mode, nN;
    __device__ __forceinline__ bool next(int i, Unit& u) const {
        const int L = i * G + c; if (L >= n) return false;
        if (mode == 0) { u.pm = L / nN; u.pn = L - u.pm * nN; }
        else if (mode == 1) {
            if (L < 544) { const int nn = L / 272, rem = L - nn * 272; u.pm = nn * 68 + (rem >> 2); u.pn = nn * 4 + (rem & 3); }
            else { const int Lp = L - 544, nn = 2 + Lp / 68; u.pm = nn * 68 + Lp % 68; u.pn = 8 + (nn - 2); }
        } else if (mode == 4) { const int nn = L / 272, rem = L - nn * 272; u.pm = rem >> 2; u.pn = nn * 4 + (rem & 3); }
        else if (mode == 3) { const int q = L >> 2; u.pm = (q >> 4) * 17 + (q & 15) + 1; u.pn = L & 3; }
        else { const int nn = L / 272, rem = L - nn * 272; u.pm = nn * 68 + (rem >> 2); u.pn = nn * 4 + (rem & 3); }
        return true;
    }
    __device__ __forceinline__ void a_ready(const Unit&) const {}
    __device__ __forceinline__ void done(const Unit&) const {}
};
template <class F> struct EpiT {
    static constexpr bool PERM = true, AFTER_DRAIN = false;
    F f;
    __device__ __forceinline__ void operator()(const f32x4 (&acc)[2][2][4][2], const Unit& u, int wr, int wc, int fr, int fq) const {
#pragma unroll
        for (int ai = 0; ai < 2; ++ai)
#pragma unroll
            for (int m = 0; m < 4; ++m)
#pragma unroll
                for (int bj = 0; bj < 2; ++bj) f(u, ai * 128 + wr * 64 + m * 16 + fr, bj * 128 + wc * 32 + 8 * fq, acc[ai][bj][m][0], acc[ai][bj][m][1]);
    }
};
template <class Epi, class Sched, bool ALIGN_EPI = false, bool SP2 = false>
__device__ __forceinline__ void gemm_phase(PG8_LAS unsigned char* lds, const Gemm g, const Sched& S, const Epi& E) {
    const int tid = threadIdx.x, wid = __builtin_amdgcn_readfirstlane(tid >> 6), lane = tid & 63, wr = wid >> 2, wc = wid & 3, fr = lane & 15, fq = lane >> 4;
    const int K = g.K, nt = K / BK;
    unsigned voffA[2], voffB[2];
#pragma unroll
    for (int i = 0; i < 2; ++i) { int R, C; stage_rc(tid * 16 + i * 8192, R, C); const int Rb = Epi::PERM ? ((R & ~31) + perm32(R & 31)) : R;
        voffA[i] = (unsigned)(R * K + C) * 2u; voffB[i] = (unsigned)(Rb * K + C) * 2u; }
    const size_t kstep = (size_t)(BK * 2);
    const size_t hstep = (size_t)HALF * K * 2;
    const size_t tstep = 2 * hstep;
    const unsigned ldsw = (unsigned)wid * 1024u;
    const int aoff = lds_byte(wr * 64 + fr, fq * 8), boff = lds_byte(wc * 32 + fr, fq * 8);
#define PG8_SA(b, h) (((b) * 2 + (h)) * HTB)
#define PG8_SB(b, h) ((4 + (b) * 2 + (h)) * HTB)
#define PG8_STAGE(bufoff, gbase, voff) do { _Pragma("unroll") for (int _i = 0; _i < 2; ++_i) \
        __builtin_amdgcn_global_load_lds((const unsigned*)((const char*)(gbase) + (voff)[_i]), (PG8_LAS unsigned*)(lds + (bufoff) + ldsw + _i * 8192), 16, 0, 0); } while (0)
#define PG8_LDA(dst, b, h) do { _Pragma("unroll") for (int m = 0; m < 4; ++m) _Pragma("unroll") for (int k = 0; k < 2; ++k) dst[m][k] = *(const PG8_LAS bf16x8*)(lds + PG8_SA(b, h) + aoff + m * 2048 + k * 1024); } while (0)
#define PG8_LDB(dst, b, h) do { _Pragma("unroll") for (int n = 0; n < 2; ++n) _Pragma("unroll") for (int k = 0; k < 2; ++k) dst[n][k] = *(const PG8_LAS bf16x8*)(lds + PG8_SB(b, h) + boff + n * 2048 + k * 1024); } while (0)
#define PG8_MMA(ai, bj, At, Bt) do { __builtin_amdgcn_s_setprio(1); _Pragma("unroll") for (int m = 0; m < 4; ++m) _Pragma("unroll") for (int n = 0; n < 2; ++n) _Pragma("unroll") for (int k = 0; k < 2; ++k) \
        acc[ai][bj][m][n] = __builtin_amdgcn_mfma_f32_16x16x32_bf16(Bt[n][k], At[m][k], acc[ai][bj][m][n], 0, 0, 0); __builtin_amdgcn_s_setprio(0); } while (0)
#define PG8_WAIT_V(n) asm volatile("s_waitcnt vmcnt(" #n ")" ::: "memory")
#define PG8_WAIT_L(n) asm volatile("s_waitcnt lgkmcnt(" #n ")" ::: "memory")
#define PG8_BAR __builtin_amdgcn_s_barrier()
#define PG8_SCHED __builtin_amdgcn_sched_barrier(0)
    Unit cur, nxt; int ui = 0;
    if (!S.next(0, cur)) return;
    f32x4 acc[2][2][4][2];
#pragma unroll
    for (int a = 0; a < 2; ++a)
#pragma unroll
        for (int b = 0; b < 2; ++b)
#pragma unroll
            for (int m = 0; m < 4; ++m)
#pragma unroll
                for (int n = 0; n < 2; ++n) acc[a][b][m][n] = (f32x4){0.f, 0.f, 0.f, 0.f};
    bf16x8 At[4][2], B0[2][2], B1[2][2];
    const char* cA = (const char*)g.A + (size_t)cur.pm * tstep; const char* cB = (const char*)g.Bt + (size_t)cur.pn * tstep;
    S.a_ready(cur);
    if constexpr (SP2) {
        PG8_STAGE(PG8_SB(0, 0), cB, voffB); PG8_STAGE(PG8_SB(0, 1), cB + hstep, voffB); PG8_STAGE(PG8_SA(0, 0), cA, voffA); PG8_STAGE(PG8_SA(0, 1), cA + hstep, voffA);
        if (wr == 1) PG8_BAR;
        PG8_WAIT_V(2); PG8_BAR;
        PG8_STAGE(PG8_SB(1, 0), cB + kstep, voffB); PG8_STAGE(PG8_SA(1, 0), cA + kstep, voffA); PG8_STAGE(PG8_SB(1, 1), cB + hstep + kstep, voffB);
        PG8_WAIT_V(6); PG8_BAR;
    } else {
        PG8_STAGE(PG8_SB(0, 0), cB, voffB); PG8_STAGE(PG8_SA(0, 0), cA, voffA); PG8_STAGE(PG8_SB(0, 1), cB + hstep, voffB); PG8_STAGE(PG8_SA(0, 1), cA + hstep, voffA);
        if (wr == 1) PG8_BAR;
        PG8_WAIT_V(4); PG8_BAR;
        PG8_STAGE(PG8_SB(1, 0), cB + kstep, voffB); PG8_STAGE(PG8_SA(1, 0), cA + kstep, voffA); PG8_STAGE(PG8_SB(1, 1), cB + hstep + kstep, voffB);
        PG8_WAIT_V(6); PG8_BAR;
    }
    for (;;) {
        const bool has_next = S.next(ui + 1, nxt);
        const char* nA = has_next ? (const char*)g.A + (size_t)nxt.pm * tstep : cA; const char* nB = has_next ? (const char*)g.Bt + (size_t)nxt.pn * tstep : cB;
        for (int t = 0; t < nt; t += 2) {
            const bool last = (t == nt - 2);
            const char* a1 = cA + (size_t)(t + 1) * kstep;
            const char* a2 = last ? nA : cA + (size_t)(t + 2) * kstep; const char* b2 = last ? nB : cB + (size_t)(t + 2) * kstep;
            const char* a3 = a2 + kstep; const char* b3 = b2 + kstep;
            if (last && has_next) S.a_ready(nxt);
            if constexpr (SP2) {
            PG8_LDB(B0, 0, 0); PG8_LDB(B1, 0, 1); PG8_SCHED; PG8_LDA(At, 0, 0); PG8_STAGE(PG8_SA(1, 1), a1 + hstep, voffA);
            PG8_WAIT_V(8); PG8_WAIT_L(0); PG8_BAR; PG8_MMA(0, 0, At, B0); PG8_MMA(0, 1, At, B1); PG8_BAR; PG8_SCHED;
            PG8_LDA(At, 0, 1); PG8_STAGE(PG8_SB(0, 0), b2, voffB); PG8_STAGE(PG8_SB(0, 1), b2 + hstep, voffB); PG8_STAGE(PG8_SA(0, 0), a2, voffA);
            PG8_WAIT_V(8); PG8_WAIT_L(0); PG8_BAR; PG8_MMA(1, 0, At, B0); PG8_MMA(1, 1, At, B1); PG8_BAR; PG8_SCHED;
            PG8_LDB(B0, 1, 0); PG8_LDB(B1, 1, 1); PG8_SCHED; PG8_LDA(At, 1, 0); PG8_STAGE(PG8_SA(0, 1), a2 + hstep, voffA);
            PG8_WAIT_V(8); PG8_WAIT_L(0); PG8_BAR; PG8_MMA(0, 0, At, B0); PG8_MMA(0, 1, At, B1); PG8_BAR; PG8_SCHED;
            PG8_LDA(At, 1, 1); PG8_STAGE(PG8_SB(1, 0), b3, voffB); PG8_STAGE(PG8_SB(1, 1), b3 + hstep, voffB); PG8_STAGE(PG8_SA(1, 0), a3, voffA);
            PG8_WAIT_V(8); PG8_WAIT_L(0); PG8_BAR; PG8_MMA(1, 0, At, B0); PG8_MMA(1, 1, At, B1); PG8_BAR; PG8_SCHED;
            } else {
            PG8_LDB(B0, 0, 0); PG8_SCHED; PG8_LDA(At, 0, 0); PG8_STAGE(PG8_SA(1, 1), a1 + hstep, voffA);
            PG8_WAIT_L(8); PG8_BAR; PG8_WAIT_L(0); PG8_MMA(0, 0, At, B0); PG8_BAR; PG8_SCHED;
            PG8_LDB(B1, 0, 1); PG8_STAGE(PG8_SB(0, 0), b2, voffB);
            PG8_BAR; PG8_WAIT_L(0); PG8_MMA(0, 1, At, B1); PG8_BAR;
            PG8_LDA(At, 0, 1); PG8_STAGE(PG8_SA(0, 0), a2, voffA);
            PG8_BAR; PG8_WAIT_L(0); PG8_MMA(1, 0, At, B0); PG8_BAR; PG8_SCHED;
            PG8_STAGE(PG8_SB(0, 1), b2 + hstep, voffB);
            PG8_WAIT_V(6); PG8_BAR; PG8_MMA(1, 1, At, B1); PG8_BAR;
            PG8_LDB(B0, 1, 0); PG8_SCHED; PG8_LDA(At, 1, 0); PG8_STAGE(PG8_SA(0, 1), a2 + hstep, voffA);
            PG8_WAIT_L(8); PG8_BAR; PG8_WAIT_L(0); PG8_MMA(0, 0, At, B0); PG8_BAR; PG8_SCHED;
            PG8_LDB(B1, 1, 1); PG8_STAGE(PG8_SB(1, 0), b3, voffB);
            PG8_BAR; PG8_WAIT_L(0); PG8_MMA(0, 1, At, B1); PG8_BAR;
            PG8_LDA(At, 1, 1); PG8_STAGE(PG8_SA(1, 0), a3, voffA);
            PG8_BAR; PG8_WAIT_L(0); PG8_MMA(1, 0, At, B0); PG8_BAR; PG8_SCHED;
            PG8_STAGE(PG8_SB(1, 1), b3 + hstep, voffB);
            PG8_WAIT_V(6); PG8_BAR; PG8_MMA(1, 1, At, B1); PG8_BAR;
            }
        }
        if constexpr (ALIGN_EPI) { if (wr == 0) PG8_BAR; }
        if constexpr (!Epi::AFTER_DRAIN) { E(acc, cur, wr, wc, fr, fq); S.done(cur); }
        if (!has_next) break;
#pragma unroll
        for (int a = 0; a < 2; ++a)
#pragma unroll
            for (int b = 0; b < 2; ++b)
#pragma unroll
                for (int m = 0; m < 4; ++m)
#pragma unroll
                    for (int n = 0; n < 2; ++n) acc[a][b][m][n] = (f32x4){0.f, 0.f, 0.f, 0.f};
        cur = nxt; cA = nA; cB = nB; ++ui;
        if constexpr (ALIGN_EPI) { if (wr == 1) PG8_BAR; }
    }
    PG8_WAIT_V(0);
    if constexpr (!ALIGN_EPI) { if (wr == 0) PG8_BAR; }
    PG8_BAR;
    if constexpr (Epi::AFTER_DRAIN) { E.fused(acc, cur, wr, wc, fr, fq, lds, wid, lane); S.done(cur); }
#undef PG8_SA
#undef PG8_SB
#undef PG8_STAGE
#undef PG8_LDA
#undef PG8_LDB
#undef PG8_MMA
#undef PG8_WAIT_V
#undef PG8_WAIT_L
#undef PG8_BAR
#undef PG8_SCHED
}
}

constexpr int NB = 4, SEQ = 4096, CTXL = 256, TB = SEQ + CTXL  , NT = NB * TB  , D = 1024, NMT = NT / 256  ;
constexpr int NWAVES = 8, NTHR = 512, GRID = 256;
constexpr size_t MiB = 1u << 20;
constexpr size_t OFF_MOD = 0, OFF_S5A = 256 * 1024, OFF_BAR = 512 * 1024, OFF_BB = 1 * MiB, OFF_L2T = 2 * MiB, OFF_CTX = 3 * MiB, OFF_WT = 7 * MiB, OFF_R0 = 18 * MiB, RSZ = 34 * MiB;
constexpr size_t WS_NEED = OFF_R0 + 7 * RSZ;
constexpr int LDS_BYTES = 147456;

typedef unsigned short bf16;
typedef float f32x4 __attribute__((ext_vector_type(4)));
typedef short bf16x8 __attribute__((ext_vector_type(8)));
typedef unsigned u32x4 __attribute__((ext_vector_type(4)));
typedef unsigned u32x2 __attribute__((ext_vector_type(2)));

__device__ __forceinline__ float bf2f(unsigned v) { return __builtin_bit_cast(float, v << 16); }
__device__ __forceinline__ unsigned f2bf(float f) { unsigned u = __builtin_bit_cast(unsigned, f); return (u + 0x7fffu + ((u >> 16) & 1u)) >> 16; }
__device__ __forceinline__ unsigned f2bf_hw(float f) { unsigned r; asm("v_cvt_pk_bf16_f32 %0, %1, %1" : "=v"(r) : "v"(f)); return r & 0xffffu; }
__device__ __forceinline__ unsigned pk2(float lo, float hi) { unsigned r; asm("v_cvt_pk_bf16_f32 %0, %1, %2" : "=v"(r) : "v"(lo), "v"(hi)); return r; }
__device__ __forceinline__ float lo_bf(unsigned w) { return __builtin_bit_cast(float, w << 16); }
__device__ __forceinline__ float hi_bf(unsigned w) { return __builtin_bit_cast(float, w & 0xffff0000u); }
__device__ __forceinline__ void store8(bf16* p, f32x4 a, f32x4 b) { u32x4 w; w.x = pk2(a.x, a.y); w.y = pk2(a.z, a.w); w.z = pk2(b.x, b.y); w.w = pk2(b.z, b.w); *(u32x4*)p = w; }
__device__ __forceinline__ float sigm(float x) { return __builtin_amdgcn_rcpf(1.f + __expf(-x)); }
__device__ __forceinline__ float tanh_fast(float x) { return 1.f - 2.f * __builtin_amdgcn_rcpf(1.f + __expf(2.f * x)); }
__device__ __forceinline__ float silu(float x) { return x * __builtin_amdgcn_rcpf(1.f + __expf(-x)); }
__device__ __forceinline__ unsigned cvt_pk_bf16(float lo, float hi) { unsigned r; asm("v_cvt_pk_bf16_f32 %0, %1, %2" : "=v"(r) : "v"(lo), "v"(hi)); return r; }
__device__ __forceinline__ bf16x8 pack8(const float (&f)[8]) { u32x4 h; h.x = pk2(f[0], f[1]); h.y = pk2(f[2], f[3]); h.z = pk2(f[4], f[5]); h.w = pk2(f[6], f[7]); return __builtin_bit_cast(bf16x8, h); }
__device__ __forceinline__ void split8(const float (&f)[8], bf16x8& hi, bf16x8& lo) {
    u32x4 h, l;
#pragma unroll
    for (int i = 0; i < 4; ++i) { const unsigned hw = cvt_pk_bf16(f[2 * i], f[2 * i + 1]); h[i] = hw; l[i] = cvt_pk_bf16(f[2 * i] - lo_bf(hw), f[2 * i + 1] - hi_bf(hw)); }
    hi = __builtin_bit_cast(bf16x8, h); lo = __builtin_bit_cast(bf16x8, l);
}
template <int CTRL> __device__ __forceinline__ float dppf(float x) { return __builtin_bit_cast(float, __builtin_amdgcn_update_dpp(0, __builtin_bit_cast(int, x), CTRL, 0xF, 0xF, false)); }
__device__ __forceinline__ float allred16(float x) { x += dppf<0x128>(x); x += dppf<0x124>(x); x += dppf<0x122>(x); x += dppf<0x121>(x); return x; }
__device__ __forceinline__ float wave_sum(float v) {
    v = allred16(v);
    const float s0 = __builtin_bit_cast(float, __builtin_amdgcn_readlane(__builtin_bit_cast(int, v), 0)), s1 = __builtin_bit_cast(float, __builtin_amdgcn_readlane(__builtin_bit_cast(int, v), 16));
    const float s2 = __builtin_bit_cast(float, __builtin_amdgcn_readlane(__builtin_bit_cast(int, v), 32)), s3 = __builtin_bit_cast(float, __builtin_amdgcn_readlane(__builtin_bit_cast(int, v), 48));
    return (s0 + s1) + (s2 + s3);
}
__device__ __forceinline__ int tokof(int s, int q) { return s == 0 ? q : (q < CTXL ? (CTXL - 1 - q) : (TB + CTXL - 1 - q)); }

struct Args { const float* in[38]; float* out; unsigned char* ws; int ph_lo, ph_hi; };

struct Fr {
    const Args* a; unsigned char* lds; unsigned char* ws; int tid, lane, wave, gw;
    __device__ __forceinline__ bf16* R(int i) const { return (bf16*)(ws + OFF_R0 + (size_t)i * RSZ); }
    __device__ __forceinline__ float* mod(int l) const { return (float*)(ws + OFF_MOD) + l * 5 * 3072; }
    __device__ __forceinline__ bf16* WT() const { return (bf16*)(ws + OFF_WT); }
    __device__ __forceinline__ float* ctxbuf() const { return (float*)(ws + OFF_CTX); }
};
__device__ __forceinline__ const float* xrow(const Fr& F, int l, int m) {
    const int b = m / TB, t = m - b * TB;
    if (t < CTXL) return (l == 0 ? F.a->in[2] : F.ctxbuf()) + (size_t)(b * CTXL + t) * D;
    return (l == 0 ? F.a->in[0] : F.a->out) + (size_t)(b * SEQ + t - CTXL) * D;
}

struct FRkv {
    bf16* o0; bf16* o1; bf16* lm;
    __device__ __forceinline__ void operator()(const pg8::Unit& u, int rl, int cl, f32x4 v0, f32x4 v1) const {
        const int nn = u.pm / NMT, pm = u.pm - nn * NMT; const size_t row = (size_t)pm * 256 + rl;
        if (nn < 2) { const int col = (u.pn - nn * 4) * 256 + cl; store8((nn ? o1 : o0) + row * D + col, v0, v1); }
        else if (cl < 128) {
            if (nn == 2) { v0.x = tanh_fast(v0.x); v0.y = tanh_fast(v0.y); v0.z = tanh_fast(v0.z); v0.w = tanh_fast(v0.w); v1.x = tanh_fast(v1.x); v1.y = tanh_fast(v1.y); v1.z = tanh_fast(v1.z); v1.w = tanh_fast(v1.w); }
            store8(lm + row * 256 + (nn - 2) * 128 + cl, v0, v1);
        }
    }
};
struct FResid {
    const float* xo; const float* co; float* xn; float* cn; const float* modl;
    __device__ __forceinline__ void operator()(const pg8::Unit& u, int rl, int cl, f32x4 v0, f32x4 v1) const {
        const int b = u.pm / 17, j = u.pm - 17 * b, col = u.pn * 256 + cl;
        const float* src; float* dst; const float* gate;
        if (j == 0) { const size_t off = (size_t)(b * CTXL + rl) * D + col; src = co + off; dst = cn + off; gate = modl + 4 * 3072 + 2048 + col; }
        else { const size_t off = (size_t)(b * SEQ + (j - 1) * 256 + rl) * D + col; src = xo + off; dst = xn + off; gate = modl + b * 3072 + 2048 + col; }
        const f32x4 a0 = *(const f32x4*)src, a1 = *(const f32x4*)(src + 4), g0 = *(const f32x4*)gate, g1 = *(const f32x4*)(gate + 4);
        *(f32x4*)dst = a0 + g0 * v0; *(f32x4*)(dst + 4) = a1 + g1 * v1;
    }
};
struct FNaIn {
    bf16* q; bf16* k; bf16* vt; bf16* z;
    __device__ __forceinline__ void operator()(const pg8::Unit& u, int rl, int cl, f32x4 v0, f32x4 v1) const {
        const int sel = u.pn >> 2, col = (u.pn & 3) * 256 + cl; const size_t row = (size_t)u.pm * 256 + rl;
        if (sel == 2) {
            const int b = u.pm / 17, t = (u.pm - 17 * b) * 256 + rl, head = col >> 6, d = col & 63;
            bf16* p = vt + ((size_t)(b * 16 + head) * 64 + d) * TB + t;
            const unsigned w0 = pk2(v0.x, v0.y), w1 = pk2(v0.z, v0.w), w2 = pk2(v1.x, v1.y), w3 = pk2(v1.z, v1.w);
            p[0] = (bf16)w0; p[TB] = (bf16)(w0 >> 16); p[2 * TB] = (bf16)w1; p[3 * TB] = (bf16)(w1 >> 16);
            p[4 * TB] = (bf16)w2; p[5 * TB] = (bf16)(w2 >> 16); p[6 * TB] = (bf16)w3; p[7 * TB] = (bf16)(w3 >> 16);
        } else { bf16* o = q + (size_t)sel * (RSZ / 2); store8(o + row * D + col, v0, v1); }
    }
};
struct FS5In {
    bf16* uo; bf16* z;
    __device__ __forceinline__ void operator()(const pg8::Unit& u, int rl, int cl, f32x4 v0, f32x4 v1) const {
        const size_t row = (size_t)u.pm * 256 + rl;
        if (u.pn < 4) store8(uo + row * D + u.pn * 256 + cl, v0, v1);
        else store8(z + row * D + (u.pn - 4) * 256 + cl, v0, v1);
    }
};
struct FGlu {
    const bf16* y; const bf16* z; const float* bias; bf16* o;
    __device__ __forceinline__ void operator()(const pg8::Unit& u, int rl, int cl, f32x4 v0, f32x4 v1) const {
        const int col = u.pn * 256 + cl; const size_t off = ((size_t)u.pm * 256 + rl) * D + col;
        const u32x4 yw = *(const u32x4*)(y + off), zw = *(const u32x4*)(z + off);
        const f32x4 b0 = *(const f32x4*)(bias + col), b1 = *(const f32x4*)(bias + col + 4);
        f32x4 r0, r1;
        r0.x = lo_bf(yw.x) * sigm(v0.x + b0.x) * silu(lo_bf(zw.x)); r0.y = hi_bf(yw.x) * sigm(v0.y + b0.y) * silu(hi_bf(zw.x));
        r0.z = lo_bf(yw.y) * sigm(v0.z + b0.z) * silu(lo_bf(zw.y)); r0.w = hi_bf(yw.y) * sigm(v0.w + b0.w) * silu(hi_bf(zw.y));
        r1.x = lo_bf(yw.z) * sigm(v1.x + b1.x) * silu(lo_bf(zw.z)); r1.y = hi_bf(yw.z) * sigm(v1.y + b1.y) * silu(hi_bf(zw.z));
        r1.z = lo_bf(yw.w) * sigm(v1.z + b1.z) * silu(lo_bf(zw.w)); r1.w = hi_bf(yw.w) * sigm(v1.w + b1.w) * silu(hi_bf(zw.w));
        store8(o + off, r0, r1);
    }
};

template <class F> __device__ __forceinline__ void run_gemm(const Fr& Fm, const bf16* A, const bf16* Bt, int K, int nunits, int mode, int nN, const F& f) {
    pg8::Gemm g{A, Bt, 0, 0, K}; const int bx = (int)blockIdx.x, cxcd = (gridDim.x == 256) ? (bx & 7) * 32 + (bx >> 3) : bx;
    pg8::ListOrder S{nunits, (int)gridDim.x, cxcd, mode, nN}; pg8::EpiT<F> E{f};
    pg8::gemm_phase<pg8::EpiT<F>, pg8::ListOrder, true, true>((PG8_LAS unsigned char*)Fm.lds, g, S, E);
}

__device__ __forceinline__ void transpose_item(const float* W, int K, int N, bf16* WT, int row_off, float* scr, int item, int lane) {
    const int nblk = N / 32, kb = item / nblk, nb = item % nblk, k0 = 64 * kb, n0 = 32 * nb;
    f32x4 v[8];
#pragma unroll
    for (int i = 0; i < 8; ++i) v[i] = *(const f32x4*)(W + (size_t)(k0 + 8 * i + (lane >> 3)) * N + n0 + 4 * (lane & 7));
#pragma unroll
    for (int i = 0; i < 8; ++i) { float* d = scr + (8 * i + (lane >> 3)) * 33 + 4 * (lane & 7); d[0] = v[i].x; d[1] = v[i].y; d[2] = v[i].z; d[3] = v[i].w; }
    asm volatile("s_waitcnt lgkmcnt(0)" ::: "memory");
    const int c = lane & 7;
#pragma unroll
    for (int j = 0; j < 4; ++j) { const int n = (lane >> 3) + 8 * j; const float* s = scr + (8 * c) * 33 + n;
        u32x4 o; o.x = pk2(s[0 * 33], s[1 * 33]); o.y = pk2(s[2 * 33], s[3 * 33]); o.z = pk2(s[4 * 33], s[5 * 33]); o.w = pk2(s[6 * 33], s[7 * 33]);
        *(u32x4*)(WT + (size_t)(row_off + n0 + n) * K + k0 + 8 * c) = o; }
    asm volatile("s_waitcnt lgkmcnt(0)" ::: "memory");
}
__device__ __forceinline__ void conv_mat(const Fr& F, const float* W, int K, int N, bf16* WT, int row_off) {
    float* scr = (float*)(F.lds + F.wave * 16384);
    const int nitems = (K / 64) * (N / 32);
    for (int it = F.gw; it < nitems; it += GRID * NWAVES) transpose_item(W, K, N, WT, row_off, scr, it, F.lane);
}
__device__ __forceinline__ void conv_rwkv(const Fr& F, int j) {
    const float* rkvg = F.a->in[8] + (size_t)j * 4 * D * D;
    conv_mat(F, rkvg, D, D, F.WT(), 0); conv_mat(F, rkvg + (size_t)D * D, D, D, F.WT(), 1024);
    conv_mat(F, rkvg + (size_t)2 * D * D, D, D, F.WT(), 2560); conv_mat(F, rkvg + (size_t)3 * D * D, D, D, F.WT(), 3584);
    for (int s = 0; s < 2; ++s) {
        conv_mat(F, F.a->in[10] + (size_t)(j * 2 + s) * D * 64, D, 64, F.WT(), 2048 + 64 * s);
        conv_mat(F, F.a->in[13] + (size_t)(j * 2 + s) * D * 64, D, 64, F.WT(), 2304 + 64 * s);
        conv_mat(F, F.a->in[11] + (size_t)(j * 2 + s) * 64 * D, 64, D, (bf16*)(F.ws + OFF_L2T) + (size_t)s * D * 64, 0);
        conv_mat(F, F.a->in[14] + (size_t)(j * 2 + s) * 64 * D, 64, D, (bf16*)(F.ws + OFF_L2T) + (size_t)(2 + s) * D * 64, 0);
    }
    conv_mat(F, F.a->in[20] + (size_t)j * D * D, D, D, F.WT(), 4608);
}

__device__ __forceinline__ void phase_mod(const Fr& F) {
    float* sc = (float*)F.lds;
    float* red = sc + 5120;
    for (int i = F.tid; i < 5120; i += NTHR) { const int j = i >> 10, k = i & 1023; const float v = j < 4 ? F.a->in[1][j * D + k] : F.a->in[3][k]; sc[i] = silu(v); }
    __syncthreads();
    for (int task = blockIdx.x; task < 192; task += gridDim.x) {
        const int l = task / 48, n0 = (task - l * 48) * 64;
        const float* wm = F.a->in[5] + (size_t)l * D * 3072 + n0 + F.lane;
        float acc[5] = {0.f, 0.f, 0.f, 0.f, 0.f};
#pragma unroll 16
        for (int kk = 0; kk < 128; ++kk) { const int k = F.wave * 128 + kk; const float w = wm[(size_t)k * 3072];
#pragma unroll
            for (int j = 0; j < 5; ++j) acc[j] += sc[j * 1024 + k] * w; }
#pragma unroll
        for (int j = 0; j < 5; ++j) red[(F.wave * 5 + j) * 64 + F.lane] = acc[j];
        __syncthreads();
        if (F.tid < 320) { const int j = F.tid >> 6, ln = F.tid & 63; float s = F.a->in[6][l * 3072 + n0 + ln];
            for (int w = 0; w < 8; ++w) s += red[(w * 5 + j) * 64 + ln];
            F.mod(l)[j * 3072 + n0 + ln] = s; }
        __syncthreads();
    }
}

template <int NR> __device__ __forceinline__ void load_rows(const Fr& F, int l, int m0, int mlo, int mhi, f32x4 (&h)[NR][4]) {
#pragma unroll
    for (int r = 0; r < NR; ++r) {
        const int m = m0 + r; const bool valid = m >= mlo && m < mhi;
        const f32x4* xr = (const f32x4*)xrow(F, l, valid ? m : mlo) + F.lane;
#pragma unroll
        for (int j = 0; j < 4; ++j) h[r][j] = valid ? xr[64 * j] : (f32x4){0.f, 0.f, 0.f, 0.f};
    }
}
template <int NR> __device__ __forceinline__ void norm_rows(const Fr& F, int l, int m0, f32x4 (&h)[NR][4]) {
    const int b = m0 / TB, t = m0 - b * TB; const float* md = F.mod(l) + (t < CTXL ? 4 : b) * 3072;
    f32x4 gs[4], sh[4];
#pragma unroll
    for (int j = 0; j < 4; ++j) { const f32x4 g = ((const f32x4*)(F.a->in[4] + l * D) + F.lane)[64 * j], sc = ((const f32x4*)(md + 1024) + F.lane)[64 * j]; gs[j] = g * (sc + 1.f); sh[j] = ((const f32x4*)md + F.lane)[64 * j]; }
    float ss[NR];
#pragma unroll
    for (int r = 0; r < NR; ++r) { ss[r] = 0.f;
#pragma unroll
        for (int j = 0; j < 4; ++j) ss[r] += (h[r][j].x * h[r][j].x + h[r][j].y * h[r][j].y) + (h[r][j].z * h[r][j].z + h[r][j].w * h[r][j].w); }
#pragma unroll
    for (int r = 0; r < NR; ++r) { const float rstd = 1.f / sqrtf(wave_sum(ss[r]) * (1.f / D) + 1e-6f);
#pragma unroll
        for (int j = 0; j < 4; ++j) h[r][j] = (h[r][j] * rstd) * gs[j] + sh[j]; }
}
__device__ __forceinline__ void store_row_bf16(bf16* orow, int lane, const f32x4 (&v)[4]) {
    u32x2* o = (u32x2*)orow + lane;
#pragma unroll
    for (int j = 0; j < 4; ++j) { u32x2 w; w.x = pk2(v[j].x, v[j].y); w.y = pk2(v[j].z, v[j].w); o[64 * j] = w; }
}
__device__ __forceinline__ void phase_norm_plain(const Fr& F, int l) {
    for (int run = F.gw; run < NT / 4; run += GRID * NWAVES) {
        const int m0 = run * 4; f32x4 h[4][4];
        load_rows<4>(F, l, m0, 0, NT, h); norm_rows<4>(F, l, m0, h);
#pragma unroll
        for (int r = 0; r < 4; ++r) store_row_bf16(F.R(0) + (size_t)(m0 + r) * D, F.lane, h[r]);
    }
}
__device__ __forceinline__ void phase_norm_mix(const Fr& F, int l, int jr, int nmix, int n0, int n1, int n2, int n3) {
    const int nidx[4] = {n0, n1, n2, n3};
    for (int run = F.gw; run < NT / 4; run += GRID * NWAVES) {
        const int m0 = run * 4, b = m0 / TB, t0 = m0 - b * TB, seg_lo = b * TB + (t0 < CTXL ? 0 : CTXL), seg_hi = b * TB + (t0 < CTXL ? CTXL : TB);
        f32x4 h[6][4];
        load_rows<6>(F, l, m0 - 1, seg_lo, seg_hi, h); norm_rows<6>(F, l, m0, h);
        if (m0 - 1 < seg_lo) {
#pragma unroll
            for (int j = 0; j < 4; ++j) h[0][j] = (f32x4){0.f, 0.f, 0.f, 0.f}; }
        if (m0 + 4 >= seg_hi) {
#pragma unroll
            for (int j = 0; j < 4; ++j) h[5][j] = (f32x4){0.f, 0.f, 0.f, 0.f}; }
#pragma unroll
        for (int q = 0; q < 4; ++q) if (q < nmix) {
            f32x4 mu[4];
#pragma unroll
            for (int j = 0; j < 4; ++j) mu[j] = ((const f32x4*)(F.a->in[7] + (size_t)(jr * 6 + nidx[q]) * D) + F.lane)[64 * j];
#pragma unroll
            for (int r = 0; r < 4; ++r) { f32x4 o[4];
#pragma unroll
                for (int j = 0; j < 4; ++j) o[j] = h[r + 1][j] + ((h[r][j] + h[r + 2][j]) * 0.5f - h[r + 1][j]) * mu[j];
                store_row_bf16(F.R(q) + (size_t)(m0 + r) * D, F.lane, o); }
        }
    }
}

typedef float f32x2 __attribute__((ext_vector_type(2)));
#define LDS_BAR() asm volatile("s_waitcnt lgkmcnt(0)\n\ts_barrier" ::: "memory")
__device__ __forceinline__ void phase_rwkv_scan(const Fr& F, int jr) {
    float* Wv = (float*)F.lds; float* KK = Wv + 4096; float* Bv = KK + 4096; float* KD = Bv + 4096; float* Rr = KD + 4096; float* Av = Rr + 4096;
    float* Vv = Av + 8192; float* Yp = Av;
    const bf16* Rb = F.R(4); const bf16* Kb = F.R(5); const bf16* Vb = F.R(2); const bf16* LM = F.R(6);
    const bf16* L2T = (const bf16*)(F.ws + OFF_L2T);
    const int lane = F.lane, wave = F.wave, tid = F.tid, l15 = lane & 15, lq = lane >> 4;
    const int bxs = (int)blockIdx.x, bxcd = (gridDim.x == 256) ? (bxs & 7) * 32 + (bxs >> 3) : bxs;
    for (int task = bxcd; task < 256; task += gridDim.x) {
        const int half = task & 1, h = (task >> 1) & 15, b = (task >> 5) & 3, s = task >> 7;
        bf16* Yb = F.R(s);
        const float* w0 = F.a->in[9] + (size_t)(jr * 2 + s) * D + h * 64; const float* a0 = F.a->in[12] + (size_t)(jr * 2 + s) * D + h * 64;
        const float* kkw = F.a->in[15] + (size_t)jr * D + h * 64; const float* kaw = F.a->in[16] + (size_t)jr * D + h * 64;
        f32x2 S01 = {0.f, 0.f}, S23 = {0.f, 0.f};
        const int ks = 4 * l15, rloc = 4 * wave + lq;
        const int pt = wave & 3, ht0 = (wave >> 2) * 2;
        const int p1 = pt * 16 + l15;
        const int p2 = tid >> 3, j8 = tid & 7, hk0 = 8 * j8;
        bf16x8 Bw[2][2], Ba[2][2]; float w0v[2], a0v[2];
#pragma unroll
        for (int hh = 0; hh < 2; ++hh) { const int hk = (ht0 + hh) * 16 + l15, e = h * 64 + hk; w0v[hh] = w0[hk]; a0v[hh] = a0[hk];
#pragma unroll
            for (int kst = 0; kst < 2; ++kst) { Bw[hh][kst] = *(const bf16x8*)(L2T + ((size_t)s * D + e) * 64 + 32 * kst + 8 * lq); Ba[hh][kst] = *(const bf16x8*)(L2T + ((size_t)(2 + s) * D + e) * 64 + 32 * kst + 8 * lq); } }
        float kkc[8], kac[8], rkc[8];
#pragma unroll
        for (int i = 0; i < 8; ++i) { kkc[i] = kkw[hk0 + i]; kac[i] = kaw[hk0 + i]; rkc[i] = F.a->in[17][(size_t)jr * D + h * 64 + hk0 + i]; }
        float* Bon = (float*)(F.ws + OFF_R0 + 6 * RSZ + 16 * MiB);
        bf16x8 Aw[2], Aa[2]; u32x4 kw, rw; u32x2 vw;
        {   const size_t row1 = (size_t)b * TB + tokof(s, p1), row2 = (size_t)b * TB + tokof(s, p2);
#pragma unroll
            for (int kst = 0; kst < 2; ++kst) { Aw[kst] = *(const bf16x8*)(LM + row1 * 256 + 64 * s + 32 * kst + 8 * lq); Aa[kst] = *(const bf16x8*)(LM + row1 * 256 + 128 + 64 * s + 32 * kst + 8 * lq); }
            kw = *(const u32x4*)(Kb + row2 * D + h * 64 + hk0); rw = *(const u32x4*)(Rb + row2 * D + h * 64 + hk0); vw = *(const u32x2*)(Vb + row2 * D + h * 64 + 32 * half + 4 * j8); }
        for (int chunk = 0; chunk < TB / 64; ++chunk) {
#pragma unroll
            for (int hh = 0; hh < 2; ++hh) {
                const int hk = (ht0 + hh) * 16 + l15;
                f32x4 cw = {0.f, 0.f, 0.f, 0.f}, ca = {0.f, 0.f, 0.f, 0.f};
#pragma unroll
                for (int kst = 0; kst < 2; ++kst) { cw = __builtin_amdgcn_mfma_f32_16x16x32_bf16(Aw[kst], Bw[hh][kst], cw, 0, 0, 0); ca = __builtin_amdgcn_mfma_f32_16x16x32_bf16(Aa[kst], Ba[hh][kst], ca, 0, 0, 0); }
#pragma unroll
                for (int reg = 0; reg < 4; ++reg) { const int pp = pt * 16 + lq * 4 + reg;
                    Wv[pp * 64 + hk] = __expf(-0.60653066f * sigm(w0v[hh] + cw[reg]));
                    Av[pp * 64 + hk] = sigm(a0v[hh] + ca[reg]); }
            }
            LDS_BAR();
            {
                const float kr[8] = {lo_bf(kw.x), hi_bf(kw.x), lo_bf(kw.y), hi_bf(kw.y), lo_bf(kw.z), hi_bf(kw.z), lo_bf(kw.w), hi_bf(kw.w)};
                const float rr[8] = {lo_bf(rw.x), hi_bf(rw.x), lo_bf(rw.y), hi_bf(rw.y), lo_bf(rw.z), hi_bf(rw.z), lo_bf(rw.w), hi_bf(rw.w)};
                float kq[8]; float ss = 0.f, bon = 0.f;
#pragma unroll
                for (int i = 0; i < 8; ++i) { kq[i] = kr[i] * kkc[i]; ss += kq[i] * kq[i]; bon += rr[i] * kr[i] * rkc[i]; }
                ss += dppf<0xB1>(ss); ss += dppf<0x4E>(ss); ss += dppf<0x141>(ss); bon += dppf<0xB1>(bon); bon += dppf<0x4E>(bon); bon += dppf<0x141>(bon);
                if (s == 0 && half == 0 && j8 == 0) Bon[((size_t)b * TB + tokof(s, chunk * 64 + p2)) * 16 + h] = bon;
                const float inv = 1.f / fmaxf(sqrtf(ss), 1e-12f);
                const f32x4 av0 = *(const f32x4*)(Av + p2 * 64 + hk0), av1 = *(const f32x4*)(Av + p2 * 64 + hk0 + 4);
                const float av[8] = {av0.x, av0.y, av0.z, av0.w, av1.x, av1.y, av1.z, av1.w};
                float o1[8], o2[8], o3[8];
#pragma unroll
                for (int i = 0; i < 8; ++i) { const float kkv = kq[i] * inv; o1[i] = kkv; o2[i] = kkv * av[i]; o3[i] = kr[i] * (1.f + (av[i] - 1.f) * kac[i]); }
                const int o = p2 * 64 + hk0;
                *(f32x4*)(KK + o) = (f32x4){o1[0], o1[1], o1[2], o1[3]}; *(f32x4*)(KK + o + 4) = (f32x4){o1[4], o1[5], o1[6], o1[7]};
                *(f32x4*)(Bv + o) = (f32x4){o2[0], o2[1], o2[2], o2[3]}; *(f32x4*)(Bv + o + 4) = (f32x4){o2[4], o2[5], o2[6], o2[7]};
                *(f32x4*)(KD + o) = (f32x4){o3[0], o3[1], o3[2], o3[3]}; *(f32x4*)(KD + o + 4) = (f32x4){o3[4], o3[5], o3[6], o3[7]};
                *(f32x4*)(Rr + o) = (f32x4){rr[0], rr[1], rr[2], rr[3]}; *(f32x4*)(Rr + o + 4) = (f32x4){rr[4], rr[5], rr[6], rr[7]};
                *(f32x4*)(Vv + p2 * 32 + 4 * j8) = (f32x4){lo_bf(vw.x), hi_bf(vw.x), lo_bf(vw.y), hi_bf(vw.y)};
            }
            if (chunk + 1 < TB / 64) {
                const size_t row1 = (size_t)b * TB + tokof(s, (chunk + 1) * 64 + p1), row2 = (size_t)b * TB + tokof(s, (chunk + 1) * 64 + p2);
#pragma unroll
                for (int kst = 0; kst < 2; ++kst) { Aw[kst] = *(const bf16x8*)(LM + row1 * 256 + 64 * s + 32 * kst + 8 * lq); Aa[kst] = *(const bf16x8*)(LM + row1 * 256 + 128 + 64 * s + 32 * kst + 8 * lq); }
                kw = *(const u32x4*)(Kb + row2 * D + h * 64 + hk0); rw = *(const u32x4*)(Rb + row2 * D + h * 64 + hk0); vw = *(const u32x2*)(Vb + row2 * D + h * 64 + 32 * half + 4 * j8);
            }
            LDS_BAR();
            {
                float* Ypw = Yp + wave * 1024;
                unsigned a1 = (unsigned)(size_t)(__attribute__((address_space(3))) float*)(Wv + ks), a2 = (unsigned)(size_t)(__attribute__((address_space(3))) float*)(Rr + ks),
                         a3 = (unsigned)(size_t)(__attribute__((address_space(3))) float*)(Vv + rloc), a4 = (unsigned)(size_t)(__attribute__((address_space(3))) float*)(Ypw + lane);
                asm volatile("" : "+v"(a1), "+v"(a2), "+v"(a3), "+v"(a4));
                typedef const __attribute__((address_space(3))) f32x4* lp4; typedef const __attribute__((address_space(3))) float* lp1; typedef __attribute__((address_space(3))) float* lw1;
                const lp4 PW = (lp4)a1, PR = (lp4)a2; const lp1 PV = (lp1)a3; const lw1 PY = (lw1)a4;
                f32x4 w4 = PW[0], k4 = PW[1024], b4 = PW[2048], d4 = PW[3072], r4 = PR[0];
                float vv = PV[0];
                for (int pg = 0; pg < 64; pg += 16) {
#pragma unroll
                    for (int pi = 0; pi < 16; ++pi) {
                        const int p = pg + pi, pn = p < 63 ? p + 1 : 63;
                        const f32x4 w4n = PW[pn * 16], k4n = PW[1024 + pn * 16], b4n = PW[2048 + pn * 16], d4n = PW[3072 + pn * 16], r4n = PR[pn * 16];
                        const float vvn = PV[pn * 32];
                        f32x2 t = S01 * k4.xy; t = S23 * k4.zw + t; float sa = t.x + t.y;
                        sa += dppf<0x128>(sa);
                        const f32x2 dv01 = d4.xy * vv, dv23 = d4.zw * vv;
                        sa += dppf<0x124>(sa);
                        const f32x2 e01 = S01 * w4.xy + dv01;
                        sa += dppf<0x122>(sa);
                        const f32x2 e23 = S23 * w4.zw + dv23;
                        sa += dppf<0x121>(sa);
                        S01 = e01 - b4.xy * sa; S23 = e23 - b4.zw * sa;
                        f32x2 u = S01 * r4.xy; u = S23 * r4.zw + u;
                        PY[pi * 64] = u.x + u.y;
                        w4 = w4n; k4 = k4n; b4 = b4n; d4 = d4n; r4 = r4n; vv = vvn;
                    }
                    asm volatile("s_waitcnt lgkmcnt(0)" ::: "memory");
                    {
                        const int j = lane >> 2, q = lane & 3; const float* yp = Ypw + j * 64 + q * 16;
                        const f32x4 a0 = *(const f32x4*)yp, a1 = *(const f32x4*)(yp + 4), a2 = *(const f32x4*)(yp + 8), a3 = *(const f32x4*)(yp + 12);
                        const f32x4 ssum = (a0 + a1) + (a2 + a3); const float yv = (ssum.x + ssum.y) + (ssum.z + ssum.w);
                        const size_t row = (size_t)b * TB + tokof(s, chunk * 64 + pg + j);
                        Yb[row * D + h * 64 + 32 * half + 4 * wave + q] = (bf16)f2bf(yv);
                    }
                    asm volatile("s_waitcnt lgkmcnt(0)" ::: "memory");
                }
            }
            LDS_BAR();
        }
        LDS_BAR();
    }
}

__device__ __forceinline__ void phase_rwkv_post(const Fr& F, int jr) {
    const float* lnw = F.a->in[18] + (size_t)jr * D; const float* lnb = F.a->in[19] + (size_t)jr * D;
    const float* Bon = (const float*)(F.ws + OFF_R0 + 6 * RSZ + 16 * MiB);
    for (int m = F.gw; m < NT; m += GRID * NWAVES) {
        const size_t base = (size_t)m * D;
        u32x2 ow[4];
#pragma unroll
        for (int j = 0; j < 4; ++j) {
            const int c = 256 * j + 4 * F.lane;
            const u32x2 y0 = *(const u32x2*)(F.R(0) + base + c), y1 = *(const u32x2*)(F.R(1) + base + c), vw = *(const u32x2*)(F.R(2) + base + c), gw = *(const u32x2*)(F.R(3) + base + c);
            const float bsum = Bon[(size_t)m * 16 + 4 * j + (F.lane >> 4)];
            float y[4] = {lo_bf(y0.x) + lo_bf(y1.x), hi_bf(y0.x) + hi_bf(y1.x), lo_bf(y0.y) + lo_bf(y1.y), hi_bf(y0.y) + hi_bf(y1.y)};
            const float v[4] = {lo_bf(vw.x), hi_bf(vw.x), lo_bf(vw.y), hi_bf(vw.y)}, g[4] = {lo_bf(gw.x), hi_bf(gw.x), lo_bf(gw.y), hi_bf(gw.y)};
            const f32x4 lw = *(const f32x4*)(lnw + c), lb = *(const f32x4*)(lnb + c);
            const float mean = allred16((y[0] + y[1]) + (y[2] + y[3])) * (1.f / 64.f);
            float q = 0.f;
#pragma unroll
            for (int i = 0; i < 4; ++i) { y[i] -= mean; q += y[i] * y[i]; }
            const float rstd = 1.f / sqrtf(allred16(q) * (1.f / 64.f) + 64e-5f);
            float o[4];
#pragma unroll
            for (int i = 0; i < 4; ++i) o[i] = (y[i] * rstd * lw[i] + lb[i] + bsum * v[i]) * silu(g[i]);
            ow[j].x = pk2(o[0], o[1]); ow[j].y = pk2(o[2], o[3]);
        }
#pragma unroll
        for (int j = 0; j < 4; ++j) *(u32x2*)(F.R(0) + base + 256 * j + 4 * F.lane) = ow[j];
    }
}

__device__ __forceinline__ void phase_na_qknorm(const Fr& F) {
    const float* qg = F.a->in[22]; const float* kg = F.a->in[23];
    const int d0 = 4 * (F.lane & 15);
    for (int m = F.gw; m < 2 * NT; m += GRID * NWAVES) {
        const int isk = m >= NT; bf16* p = F.R(1 + isk) + (size_t)(m - isk * NT) * D; const float* g = isk ? kg : qg; const float sc = isk ? 1.f : 0.125f;
#pragma unroll
        for (int j = 0; j < 4; ++j) {
            u32x2* pp = (u32x2*)(p + 256 * j + 4 * F.lane); const u32x2 w = *pp;
            float x[4] = {lo_bf(w.x), hi_bf(w.x), lo_bf(w.y), hi_bf(w.y)};
            const float ss = allred16((x[0] * x[0] + x[1] * x[1]) + (x[2] * x[2] + x[3] * x[3]));
            const float rstd = sc / sqrtf(ss * (1.f / 64.f) + 1e-6f);
            u32x2 o; o.x = pk2(x[0] * rstd * g[d0], x[1] * rstd * g[d0 + 1]); o.y = pk2(x[2] * rstd * g[d0 + 2], x[3] * rstd * g[d0 + 3]);
            *pp = o;
        }
    }
}
__device__ __forceinline__ void phase_na_attn(const Fr& F) {
    constexpr int KST = 72;
    bf16* KV = (bf16*)F.lds;
    float* rpbT = (float*)(F.lds + 36864 + 8 * 1536);
    const bf16* Qn = F.R(1); const bf16* Kn = F.R(2); const bf16* VT = F.R(3); const bf16* Z = F.R(4); bf16* Og = F.R(5);
    const int lane = F.lane, l15 = lane & 15, lq = lane >> 4, wave = F.wave, tid = F.tid;
    const int srow = tid >> 3, spart = (tid & 7) * 8;
    const int bxa = (int)blockIdx.x, bxcda = (gridDim.x == 256) ? (bxa & 7) * 32 + (bxa >> 3) : bxa;
    for (int bt = bxcda; bt < 2048 + 128; bt += gridDim.x) {
        int b, h, nrows, rlo = 0, gi = 0, q0 = 0, lo = 0, r0 = 0, qrow0;
        if (bt < 2048) { const int ip = bt & 31; h = (bt >> 5) & 15; b = bt >> 9; gi = 2 * ip + (wave >> 2); const int qt = wave & 3; q0 = 16 * qt; lo = qt == 0 ? 0 : (qt == 1 ? 8 : (qt == 2 ? 24 : 32));
            r0 = min(max(gi - 4, 0), 56); rlo = min(max(2 * ip - 4, 0), 56); nrows = min(max(2 * ip - 3, 0), 56) + 8 - rlo; qrow0 = b * TB + CTXL + gi * 64 + q0; }
        else { const int idx = bt - 2048; b = idx >> 5; h = (idx >> 1) & 15; nrows = 0; qrow0 = b * TB + 16 * (8 * (idx & 1) + wave); }
        const int ntl = nrows + 4;
        int boff[2][4];
#pragma unroll
        for (int st = 0; st < 2; ++st)
#pragma unroll
            for (int reg = 0; reg < 4; ++reg) { const int c = lo + 16 * st + 4 * lq + reg, qc = q0 + l15, cs = min(max(qc - 8, 0), 48); boff[st][reg] = (c >= cs && c < cs + 16) ? c - qc + 15 : -1; }
        __syncthreads();
        if (tid < 465) rpbT[tid] = F.a->in[24][h * 465 + tid];
        bf16x8 Qf[2];
#pragma unroll
        for (int ds = 0; ds < 2; ++ds) Qf[ds] = *(const bf16x8*)(Qn + (size_t)(qrow0 + l15) * D + h * 64 + 32 * ds + 8 * lq);
        f32x4 O[4]; float lsum = 0.f;
#pragma unroll
        for (int dt = 0; dt < 4; ++dt) O[dt] = (f32x4){0.f, 0.f, 0.f, 0.f};
        const bf16* Kg = Kn + (size_t)b * TB * D + h * 64 + spart + (size_t)srow * D;
        const bf16* Vg = VT + ((size_t)(b * 16 + h) * 64 + srow) * TB + spart;
        u32x4 kr0, vr0, kr1, vr1;
#define NA_T0(TN) ((TN) < nrows ? CTXL + (rlo + (TN)) * 64 : 64 * ((TN) - nrows))
        { const int t0 = NA_T0(0); kr0 = *(const u32x4*)(Kg + (size_t)t0 * D); vr0 = *(const u32x4*)(Vg + t0); }
        { const int t1 = NA_T0(1); kr1 = *(const u32x4*)(Kg + (size_t)t1 * D); vr1 = *(const u32x4*)(Vg + t1); }
        *(u32x4*)(KV + srow * KST + spart) = kr0; *(u32x4*)(KV + 64 * KST + srow * KST + spart) = vr0;
        __syncthreads();
#define NA_STEP(KR_NEXT, VR_NEXT, KR_LOAD, VR_LOAD) do { \
            if (tix + 2 < ntl) { const int t2 = NA_T0(tix + 2); KR_LOAD = *(const u32x4*)(Kg + (size_t)t2 * D); VR_LOAD = *(const u32x4*)(Vg + t2); } \
            na_tile(); \
            if (tix + 1 < ntl) { bf16* Kw = KV + ((tix + 1) & 1) * (128 * KST); *(u32x4*)(Kw + srow * KST + spart) = KR_NEXT; *(u32x4*)(Kw + 64 * KST + srow * KST + spart) = VR_NEXT; } \
            __syncthreads(); } while (0)
        int tix = 0;
        auto na_tile = [&]() {
            const bf16* Kl = KV + (tix & 1) * (128 * KST); const bf16* Vl = Kl + 64 * KST;
            const bool nb = tix < nrows; const int rr = rlo + tix;
            const bool mine = nb ? (rr >= r0 && rr < r0 + 8) : true;
            if (mine) {
                const int nsub = nb ? 1 : 2;
                for (int sub = 0; sub < nsub; ++sub) {
                    const int koff = nb ? lo : 32 * sub;
                    f32x4 Sx[2];
#pragma unroll
                    for (int st = 0; st < 2; ++st) { Sx[st] = (f32x4){0.f, 0.f, 0.f, 0.f};
#pragma unroll
                        for (int ds = 0; ds < 2; ++ds) { const bf16x8 Kf = *(const bf16x8*)(Kl + (koff + 16 * st + l15) * KST + 32 * ds + 8 * lq);
                            Sx[st] = __builtin_amdgcn_mfma_f32_16x16x32_bf16(Kf, Qf[ds], Sx[st], 0, 0, 0); } }
                    float pv[2][4];
#pragma unroll
                    for (int st = 0; st < 2; ++st)
#pragma unroll
                        for (int reg = 0; reg < 4; ++reg) {
                            if (nb) { const int bo = boff[st][reg]; pv[st][reg] = bo >= 0 ? __expf(Sx[st][reg] + rpbT[(rr - gi + 7) * 31 + bo]) : 0.f; }
                            else pv[st][reg] = __expf(Sx[st][reg]); }
                    u32x4 pw; pw.x = f2bf(pv[0][0]) | (f2bf(pv[0][1]) << 16); pw.y = f2bf(pv[0][2]) | (f2bf(pv[0][3]) << 16); pw.z = f2bf(pv[1][0]) | (f2bf(pv[1][1]) << 16); pw.w = f2bf(pv[1][2]) | (f2bf(pv[1][3]) << 16);
                    lsum += ((lo_bf(pw.x) + hi_bf(pw.x)) + (lo_bf(pw.y) + hi_bf(pw.y))) + ((lo_bf(pw.z) + hi_bf(pw.z)) + (lo_bf(pw.w) + hi_bf(pw.w)));
                    const bf16x8 Pb = __builtin_bit_cast(bf16x8, pw);
#pragma unroll
                    for (int dt = 0; dt < 4; ++dt) { const bf16* vp = Vl + (16 * dt + l15) * KST + koff + 4 * lq;
                        u32x4 vw; const u32x2 v0 = *(const u32x2*)vp, v1 = *(const u32x2*)(vp + 16); vw.x = v0.x; vw.y = v0.y; vw.z = v1.x; vw.w = v1.y;
                        O[dt] = __builtin_amdgcn_mfma_f32_16x16x32_bf16(__builtin_bit_cast(bf16x8, vw), Pb, O[dt], 0, 0, 0); }
                }
            }
        };
        for (; tix + 1 < ntl; tix += 2) { NA_STEP(kr1, vr1, kr0, vr0); ++tix; NA_STEP(kr0, vr0, kr1, vr1); --tix; }
        if (tix < ntl) { NA_STEP(kr1, vr1, kr0, vr0); }
#undef NA_STEP
#undef NA_T0
        {
            float lt = lsum; lt += __shfl_xor(lt, 16); lt += __shfl_xor(lt, 32);
            const float inv = 1.f / lt; const size_t row = (size_t)(qrow0 + l15) * D + h * 64 + 4 * lq;
#pragma unroll
            for (int dt = 0; dt < 4; ++dt) { const u32x2 zw = *(const u32x2*)(Z + row + 16 * dt);
                u32x2 o; o.x = pk2(O[dt][0] * inv * silu(lo_bf(zw.x)), O[dt][1] * inv * silu(hi_bf(zw.x))); o.y = pk2(O[dt][2] * inv * silu(lo_bf(zw.y)), O[dt][3] * inv * silu(hi_bf(zw.y)));
                *(u32x2*)(Og + row + 16 * dt) = o; }
        }
    }
}

__device__ __forceinline__ void phase_s5_params(const Fr& F) {
    const int idx = blockIdx.x * NTHR + F.tid; if (idx >= 8192) return;
    const int p = idx & 63, g = (idx >> 6) & 63, s = idx >> 12;
    const float lr = F.a->in[27][idx], li = F.a->in[28][idx], step = expf(F.a->in[29][s * 64 + g]);
    const float mag = expf(lr * step), ar = mag * cosf(li * step), ai = mag * sinf(li * step), den = lr * lr + li * li;
    const float qr = ((ar - 1.f) * lr + ai * li) / den, qi = (ai * lr - (ar - 1.f) * li) / den;
    float pr = ar, pi = ai;
    for (int i = 0; i < 6; ++i) { const float nr = pr * pr - pi * pi, ni = 2.f * pr * pi; pr = nr; pi = ni; }
    float* A = (float*)(F.ws + OFF_S5A) + idx * 4; A[0] = ar; A[1] = ai; A[2] = pr; A[3] = pi;
    float* BB = (float*)(F.ws + OFF_BB) + (size_t)idx * 32;
    const float* br = F.a->in[30] + ((size_t)g * 64 + p) * 16; const float* bi = F.a->in[31] + ((size_t)g * 64 + p) * 16;
    for (int c = 0; c < 16; ++c) { BB[c] = qr * br[c] - qi * bi[c]; BB[16 + c] = qr * bi[c] + qi * br[c]; }
}
template <bool FINAL> __device__ __forceinline__ void phase_s5_scan(const Fr& F) {
    const bf16* U = F.R(1); float* E = (float*)F.R(6);
    float* BUl = (float*)(F.lds + F.wave * 16384);
    const int lane = F.lane, l15 = lane & 15, lq = lane >> 4;
    const float* BBf = (const float*)(F.ws + OFF_BB);
    const int sg = F.gw >> 4, g = sg & 63, s = sg >> 6;
    const f32x4 av = *(const f32x4*)((const float*)(F.ws + OFF_S5A) + (sg * 64 + lane) * 4);
    const float ar = av.x, ai = av.y;
    bf16x8 B1[8];
#pragma unroll
    for (int nt = 0; nt < 8; ++nt) {
        const int n = 16 * nt + l15; const float* bp = BBf + (size_t)(sg * 64 + (n & 63)) * 32 + 16 * (n >> 6) + 8 * (lq & 1);
        const f32x4 t0 = *(const f32x4*)bp, t1 = *(const f32x4*)(bp + 4); const float f[8] = {t0.x, t0.y, t0.z, t0.w, t1.x, t1.y, t1.z, t1.w};
        B1[nt] = lq < 2 ? pack8(f) : (bf16x8){0, 0, 0, 0, 0, 0, 0, 0};
    }
    bf16x8 Chi[4];
    if (FINAL) {
#pragma unroll
        for (int ks = 0; ks < 4; ++ks) {
            const int k = 32 * ks + 8 * lq; const float* cp = (k < 64 ? F.a->in[32] : F.a->in[33]) + (size_t)g * 1024 + l15 * 64 + (k & 63); const float sg_ = k < 64 ? 1.f : -1.f;
            const f32x4 t0 = *(const f32x4*)cp, t1 = *(const f32x4*)(cp + 4); const float f[8] = {sg_ * t0.x, sg_ * t0.y, sg_ * t0.z, sg_ * t0.w, sg_ * t1.x, sg_ * t1.y, sg_ * t1.z, sg_ * t1.w};
            Chi[ks] = pack8(f);
        }
    }
    u32x4 ua[4]; float e0 = 0.f, e1 = 0.f;
    {   const int ti = F.gw & 15, b = ti / 68, chunk = ti - b * 68;
#pragma unroll
        for (int sb = 0; sb < 4; ++sb) ua[sb] = lq < 2 ? *(const u32x4*)(U + ((size_t)b * TB + tokof(s, chunk * 64 + sb * 16 + l15)) * D + g * 16 + 8 * lq) : (u32x4){0u, 0u, 0u, 0u};
        if (FINAL) { const float* e = E + ((size_t)(((s * 4 + b) * 64 + g) * 68 + chunk) * 64 + lane) * 2; e0 = e[0]; e1 = e[1]; } }
    for (int ti = (F.gw & 15); ti < NB * 68; ti += 16) {
        const int b = ti / 68, chunk = ti - b * 68, sbg = (s * 4 + b) * 64 + g, task = sbg * 68 + chunk;
        float xr = FINAL ? e0 : 0.f, xi = FINAL ? e1 : 0.f;
        bf16* Yb = F.R(4 + s);
        u32x4 uc[4];
#pragma unroll
        for (int sb = 0; sb < 4; ++sb) uc[sb] = ua[sb];
        if (ti + 16 < NB * 68) {
            const int tn = ti + 16, bn = tn / 68, cn = tn - bn * 68;
#pragma unroll
            for (int sb = 0; sb < 4; ++sb) ua[sb] = lq < 2 ? *(const u32x4*)(U + ((size_t)bn * TB + tokof(s, cn * 64 + sb * 16 + l15)) * D + g * 16 + 8 * lq) : (u32x4){0u, 0u, 0u, 0u};
            if (FINAL) { const float* e = E + ((size_t)(((s * 4 + bn) * 64 + g) * 68 + cn) * 64 + lane) * 2; e0 = e[0]; e1 = e[1]; }
        }
#pragma unroll
        for (int sub = 0; sub < 4; ++sub) {
            const bf16x8 A1 = __builtin_bit_cast(bf16x8, uc[sub]);
#pragma unroll
            for (int nt = 0; nt < 8; ++nt) {
                f32x4 acc = {0.f, 0.f, 0.f, 0.f};
                acc = __builtin_amdgcn_mfma_f32_16x16x32_bf16(A1, B1[nt], acc, 0, 0, 0);
#pragma unroll
                for (int reg = 0; reg < 4; ++reg) BUl[(4 * lq + reg) * 132 + 16 * nt + l15] = acc[reg];
            }
            asm volatile("s_waitcnt lgkmcnt(0)" ::: "memory");
#pragma unroll 4
            for (int jj = 0; jj < 16; ++jj) {
                const float br_ = BUl[jj * 132 + lane], bi_ = BUl[jj * 132 + 64 + lane];
                const float nr = ar * xr - ai * xi + br_, ni = ar * xi + ai * xr + bi_; xr = nr; xi = ni;
                if (FINAL) { BUl[jj * 132 + lane] = xr; BUl[jj * 132 + 64 + lane] = xi; }
            }
            if (FINAL) {
                asm volatile("s_waitcnt lgkmcnt(0)" ::: "memory");
                f32x4 acc = {0.f, 0.f, 0.f, 0.f};
#pragma unroll
                for (int ks = 0; ks < 4; ++ks) {
                    const f32x4 t0 = *(const f32x4*)(BUl + l15 * 132 + 32 * ks + 8 * lq), t1 = *(const f32x4*)(BUl + l15 * 132 + 32 * ks + 8 * lq + 4);
                    const float xf[8] = {t0.x, t0.y, t0.z, t0.w, t1.x, t1.y, t1.z, t1.w};
                    acc = __builtin_amdgcn_mfma_f32_16x16x32_bf16(pack8(xf), Chi[ks], acc, 0, 0, 0);
                }
#pragma unroll
                for (int reg = 0; reg < 4; ++reg) { const int tok = tokof(s, chunk * 64 + sub * 16 + 4 * lq + reg);
                    Yb[((size_t)b * TB + tok) * D + g * 16 + l15] = (bf16)f2bf(acc[reg]); }
                asm volatile("s_waitcnt lgkmcnt(0)" ::: "memory");
            }
        }
        if (!FINAL) { float* e = E + ((size_t)task * 64 + lane) * 2; e[0] = xr; e[1] = xi; }
    }
}
__device__ __forceinline__ void phase_s5_carry(const Fr& F) {
    const int idx = blockIdx.x * NTHR + F.tid; if (idx >= 2 * NB * 64 * 64) return;
    const int p = idx & 63, sbg = idx >> 6, g = sbg & 63, s = sbg >> 8;
    const f32x4 av = *(const f32x4*)((const float*)(F.ws + OFF_S5A) + ((s * 64 + g) * 64 + p) * 4);
    float* E = (float*)F.R(6) + ((size_t)sbg * 68 * 64 + p) * 2;
    float er[68], ei[68];
#pragma unroll
    for (int c = 0; c < 68; ++c) { er[c] = E[(size_t)c * 128]; ei[c] = E[(size_t)c * 128 + 1]; }
    float cr = 0.f, ci = 0.f;
#pragma unroll
    for (int c = 0; c < 68; ++c) { E[(size_t)c * 128] = cr; E[(size_t)c * 128 + 1] = ci;
        const float nr = av.z * cr - av.w * ci + er[c], ni = av.z * ci + av.w * cr + ei[c]; cr = nr; ci = ni; }
}
__device__ __forceinline__ void phase_s5_combine(const Fr& F) {
    const bf16* U = F.R(1); const float* dsk = F.a->in[34];
    for (size_t i = (size_t)blockIdx.x * NTHR + F.tid; i < (size_t)NT * D / 4; i += (size_t)GRID * NTHR) {
        const size_t e = i * 4; const int c = (int)(e & 1023);
        const u32x2 y0 = *(const u32x2*)(F.R(4) + e), y1 = *(const u32x2*)(F.R(5) + e), uw = *(const u32x2*)(U + e); const f32x4 d = *(const f32x4*)(dsk + c);
        float y[4] = {lo_bf(y0.x) + lo_bf(y1.x) + d.x * lo_bf(uw.x), hi_bf(y0.x) + hi_bf(y1.x) + d.y * hi_bf(uw.x), lo_bf(y0.y) + lo_bf(y1.y) + d.z * lo_bf(uw.y), hi_bf(y0.y) + hi_bf(y1.y) + d.w * hi_bf(uw.y)};
#pragma unroll
        for (int k = 0; k < 4; ++k) { const float x = y[k]; y[k] = 0.5f * x * (1.f + tanh_fast(0.7978845608f * (x + 0.044715f * x * x * x))); }
        u32x2 o; o.x = pk2(y[0], y[1]); o.y = pk2(y[2], y[3]); *(u32x2*)(F.R(0) + e) = o;
    }
}

#define LAS __attribute__((address_space(3)))
#define XB_TMO      128
#define XB_XCNT(j)  (256  + 64 * (j))
#define XB_XSUB(j)  (1280 + 64 * (j))
#define XB_XGEN(j)  (2304 + 64 * (j))
#define XB_TOP      3328
#define XB_TOPGEN   3392
#define XCD_BAR_WORDS 3456
#define XB_SPIN_CAP (1u << 18)

__device__ __forceinline__ unsigned xb_ld(unsigned* p)              { return __hip_atomic_load(p, __ATOMIC_RELAXED, __HIP_MEMORY_SCOPE_AGENT); }
__device__ __forceinline__ unsigned xb_add(unsigned* p, unsigned v) { return __hip_atomic_fetch_add(p, v, __ATOMIC_RELAXED, __HIP_MEMORY_SCOPE_AGENT); }
__device__ __forceinline__ unsigned xb_xcc_id() { return (unsigned)__builtin_amdgcn_s_getreg((3 << 11) | 20) & 0xFu; }
#define XB_SPIN(cond, bar) do { unsigned _sp = 0; while (cond) { __builtin_amdgcn_s_sleep(1); \
    if ((++_sp & 255u) == 0u) { if (xb_ld(&(bar)[XB_TMO])) break; if (_sp > XB_SPIN_CAP) { atomicAdd(&(bar)[XB_TMO], 1u); break; } } } } while (0)

struct XcdBarrier {
    unsigned* bar; unsigned x;
    volatile LAS unsigned* st;
};

__device__ __forceinline__ XcdBarrier xcd_barrier_post(unsigned* bar, volatile LAS unsigned* st) {
    XcdBarrier b; b.bar = bar; b.x = xb_xcc_id(); b.st = st;
    if (threadIdx.x == 0) (void)xb_add(&bar[XB_XCNT(b.x)], 1u);
    return b;
}
__device__ __forceinline__ void xcd_barrier_complete(unsigned* bar, unsigned x, unsigned& nloc, unsigned& nx) {
    const unsigned G = gridDim.x * gridDim.y * gridDim.z;
    unsigned sum, cnt, mine, sp = 0u;
    for (;;) {
        sum = 0u; cnt = 0u; mine = 0u;
#pragma unroll
        for (unsigned j = 0; j < 16; ++j) { const unsigned c = xb_ld(&bar[XB_XCNT(j)]); sum += c; cnt += (c > 0u) ? 1u : 0u; mine = (j == x) ? c : mine; }
        if (sum == G) break;
        __builtin_amdgcn_s_sleep(1);
        if ((++sp & 255u) == 0u) { if (xb_ld(&bar[XB_TMO])) break; if (sp > XB_SPIN_CAP) { atomicAdd(&bar[XB_TMO], 1u); break; } }
    }
    nloc = mine > 0u ? mine : 1u; nx = cnt > 0u ? cnt : 1u;
}

__device__ __forceinline__ void xcd_barrier(const XcdBarrier& b) {
    asm volatile("s_waitcnt vmcnt(0)" ::: "memory");
    __syncthreads();
    if (threadIdx.x == 0) {
        unsigned* bar = b.bar;
        __builtin_amdgcn_s_waitcnt(0);
        unsigned nloc = b.st[0], nx = b.st[1];
        if (nloc == 0u) { xcd_barrier_complete(bar, b.x, nloc, nx); b.st[0] = nloc; b.st[1] = nx; }
        const unsigned old = xb_add(&bar[XB_XSUB(b.x)], 1u);
        const unsigned gen = old / nloc;
        if (old + 1u == (gen + 1u) * nloc) {
            __builtin_amdgcn_fence(__ATOMIC_RELEASE, "agent");
            asm volatile("s_waitcnt vmcnt(0)" ::: "memory");
            const unsigned og = xb_add(&bar[XB_TOP], 1u);
            const unsigned tg = og / nx;
            if (og + 1u == (tg + 1u) * nx) xb_add(&bar[XB_TOPGEN], 1u);
            else XB_SPIN(xb_ld(&bar[XB_TOPGEN]) == tg, bar);
            __builtin_amdgcn_fence(__ATOMIC_ACQUIRE, "agent");
            xb_add(&bar[XB_XGEN(b.x)], 1u);
            asm volatile("s_waitcnt vmcnt(0)" ::: "memory");
        } else {
            XB_SPIN(xb_ld(&bar[XB_XGEN(b.x)]) == gen, bar);
            __builtin_amdgcn_fence(__ATOMIC_ACQUIRE, "agent");
            asm volatile("s_waitcnt vmcnt(0)" ::: "memory");
        }
    }
    __syncthreads();
}

constexpr int NPHASE = 28;
#ifndef PROBE_MASK
#define PROBE_MASK 0
#endif
__device__ __forceinline__ void phase_na_qknorm_dummy(const Fr& F) {}

#define PH(k) if (args.ph_lo <= (k) && (k) < args.ph_hi)
#define SEAM(k) if (args.ph_lo <= (k) && (k) + 1 < args.ph_hi) { if ((k) == 0) grid.sync(); else { xcd_barrier(bar); if (PROBE_MASK & 32) { xcd_barrier(bar); xcd_barrier(bar); } } }
#define RWKV_LAYER(P0, L, JR, XO, CO, OUTN, OUTMODE) \
    PH(P0 + 0) { if (L == 3) conv_rwkv(F, 1); phase_norm_mix(F, L, JR, 4, 0, 1, 4, 5); } SEAM(P0 + 0); \
    if (PROBE_MASK & 8) { phase_norm_mix(F, L, JR, 4, 0, 1, 4, 5); xcd_barrier(bar); } \
    PH(P0 + 1) { run_gemm(F, F.R(0), F.WT(), D, 680, 1, 0, FRkv{F.R(4), F.R(5), F.R(6)}); } SEAM(P0 + 1); \
    if (PROBE_MASK & 16) { run_gemm(F, F.R(0), F.WT(), D, 680, 1, 0, FRkv{F.R(4), F.R(5), F.R(6)}); xcd_barrier(bar); } \
    PH(P0 + 2) { phase_norm_mix(F, L, JR, 2, 2, 3, 0, 0); } SEAM(P0 + 2); \
    PH(P0 + 3) { run_gemm(F, F.R(0), F.WT() + (size_t)2560 * D, D, 544, 2, 0, FRkv{F.R(2), F.R(3), nullptr}); } SEAM(P0 + 3); \
    PH(P0 + 4) { phase_rwkv_scan(F, JR); } SEAM(P0 + 4); \
    if (PROBE_MASK & 1) { phase_rwkv_scan(F, JR); xcd_barrier(bar); } \
    PH(P0 + 5) { phase_rwkv_post(F, JR); } SEAM(P0 + 5); \
    PH(P0 + 6) { run_gemm(F, F.R(0), F.WT() + (size_t)4608 * D, D, OUTN, OUTMODE, 4, FResid{XO, CO, args.out, F.ctxbuf(), F.mod(L)}); } SEAM(P0 + 6);
__global__ void __launch_bounds__(NTHR) fwd_kernel(Args args) {
    extern __shared__ __attribute__((aligned(16))) unsigned char lds[];
    cg::grid_group grid = cg::this_grid();
    Fr F; F.a = &args; F.lds = lds; F.ws = args.ws; F.tid = threadIdx.x; F.lane = F.tid & 63; F.wave = __builtin_amdgcn_readfirstlane(F.tid >> 6); F.gw = blockIdx.x * NWAVES + F.wave;
    volatile LAS unsigned* bst = (volatile LAS unsigned*)((LAS unsigned char*)lds + 131072 + 1024);
    if (F.tid < 2) bst[F.tid] = 0u;
    __syncthreads();
    XcdBarrier bar = xcd_barrier_post((unsigned*)(args.ws + OFF_BAR), bst);
    PH(0) { phase_mod(F); conv_rwkv(F, 0); phase_s5_params(F); } SEAM(0);
    RWKV_LAYER(1, 0, 0, args.in[0], args.in[2], 272, 0)
    PH(8) { conv_mat(F, args.in[21], D, 4 * D, F.WT(), 0); conv_mat(F, args.in[25], D, D, F.WT(), 4096); phase_norm_plain(F, 1); } SEAM(8);
    PH(9) { run_gemm(F, F.R(0), F.WT(), D, 1088, 0, 16, FNaIn{F.R(1), F.R(2), F.R(3), F.R(4)}); } SEAM(9);
    PH(10) { phase_na_qknorm(F); } SEAM(10);
    PH(11) { phase_na_attn(F); } SEAM(11);
    if (PROBE_MASK & 4) { phase_na_attn(F); xcd_barrier(bar); }
    PH(12) { run_gemm(F, F.R(5), F.WT() + (size_t)4096 * D, D, 272, 0, 4, FResid{args.out, F.ctxbuf(), args.out, F.ctxbuf(), F.mod(1)}); } SEAM(12);
    PH(13) { conv_mat(F, args.in[26], D, 2 * D, F.WT(), 0); conv_mat(F, args.in[35], D, D, F.WT(), 2048); conv_mat(F, args.in[37], D, D, F.WT(), 3072); phase_norm_plain(F, 2); } SEAM(13);
    PH(14) { run_gemm(F, F.R(0), F.WT(), D, 544, 0, 8, FS5In{F.R(1), F.R(3)}); } SEAM(14);
    PH(15) { phase_s5_scan<false>(F); } SEAM(15);
    PH(16) { phase_s5_carry(F); } SEAM(16);
    PH(17) { phase_s5_scan<true>(F); } SEAM(17);
    if (PROBE_MASK & 2) { phase_s5_scan<false>(F); grid.sync(); phase_s5_carry(F); grid.sync(); phase_s5_scan<true>(F); xcd_barrier(bar); }
    PH(18) { phase_s5_combine(F); } SEAM(18);
    PH(19) { run_gemm(F, F.R(0), F.WT() + (size_t)2048 * D, D, 272, 0, 4, FGlu{F.R(0), F.R(3), args.in[36], F.R(4)}); } SEAM(19);
    PH(20) { run_gemm(F, F.R(4), F.WT() + (size_t)3072 * D, D, 272, 0, 4, FResid{args.out, F.ctxbuf(), args.out, F.ctxbuf(), F.mod(2)}); } SEAM(20);
    RWKV_LAYER(21, 3, 1, args.out, F.ctxbuf(), 256, 3)
}

#ifndef MULTI_LAUNCH
#define MULTI_LAUNCH 0
#endif
extern "C" void kernel_launch(void* const* d_in, const int* in_sizes, int n_in, void* d_out, int out_size, void* d_ws, size_t ws_size, hipStream_t stream) {
    static int ready = 0;
    if (ready == 0) {
        ready = -1;
        if (n_in != 38 || ws_size < WS_NEED || out_size != NB * SEQ * D) { fprintf(stderr, "kernel_launch: unexpected problem (n_in %d ws %zu out %d)\n", n_in, ws_size, out_size); return; }
        if (hipFuncSetAttribute((const void*)fwd_kernel, hipFuncAttributeMaxDynamicSharedMemorySize, LDS_BYTES) != hipSuccess) { fprintf(stderr, "kernel_launch: hipFuncSetAttribute failed\n"); return; }
        int dev = 0, cus = 0, per_cu = 0;
        hipGetDevice(&dev); hipDeviceGetAttribute(&cus, hipDeviceAttributeMultiprocessorCount, dev);
        hipOccupancyMaxActiveBlocksPerMultiprocessor(&per_cu, (const void*)fwd_kernel, NTHR, LDS_BYTES);
        if (cus * per_cu < GRID) { fprintf(stderr, "kernel_launch: grid of %d not resident (%d CUs x %d)\n", GRID, cus, per_cu); return; }
        ready = 1;
    }
    if (ready < 0) return;
    if (hipMemsetAsync((char*)d_ws + OFF_BAR, 0, XCD_BAR_WORDS * 4, stream) != hipSuccess) { fprintf(stderr, "kernel_launch: memset failed\n"); return; }
    Args a{};
    for (int i = 0; i < 38; ++i) a.in[i] = (const float*)d_in[i];
    a.out = (float*)d_out; a.ws = (unsigned char*)d_ws;
#if MULTI_LAUNCH
    for (int ph = 0; ph < NPHASE; ++ph) { a.ph_lo = ph; a.ph_hi = ph + 1; hipLaunchKernelGGL(fwd_kernel, dim3(GRID), dim3(NTHR), LDS_BYTES, stream, a); }
#else
    a.ph_lo = 0; a.ph_hi = NPHASE;
    void* kargs[] = {&a};
    hipError_t e = hipLaunchCooperativeKernel((const void*)fwd_kernel, dim3(GRID), dim3(NTHR), kargs, LDS_BYTES, stream);
    if (e != hipSuccess) fprintf(stderr, "cooperative launch failed: %s\n", hipGetErrorString(e));
#endif
}
```

```cpp
#include <hip/hip_runtime.h>
#include <hip/hip_cooperative_groups.h>
#include <cstdio>
#include <cstdint>
namespace cg = cooperative_groups;

namespace pg8 {
#define PG8_LAS __attribute__((address_space(3)))
typedef unsigned short bf16_t;
typedef short bf16x8 __attribute__((ext_vector_type(8)));
typedef float f32x4 __attribute__((ext_vector_type(4)));
typedef unsigned u32x4 __attribute__((ext_vector_type(4)));
constexpr int BM = 256, BK = 64, HALF = 128, HTB = HALF * BK * 2  , STAGE_BYTES = 8 * HTB, NXCD = 8, WGM = 8;

__host__ __device__ __forceinline__ int lds_byte(int r, int c) { const int st = (r >> 4) * 2 + (c >> 5), rr = r & 15, cc = c & 31, ob = rr * 64 + cc * 2; return st * 1024 + (ob ^ (((ob >> 9) & 1) << 5)); }
__host__ __device__ __forceinline__ void stage_rc(int b, int& R, int& C) { const int st = b / 1024, sb = b % 1024, swz = sb ^ (((sb >> 9) & 1) << 5); R = (st >> 1) * 16 + swz / 64; C = (st & 1) * 32 + (swz % 64) / 2; }
__host__ __device__ __forceinline__ int perm32(int rho) { const int n = rho >> 4, i = rho & 15; return 8 * (i >> 2) + 4 * n + (i & 3); }

struct Unit { int pm, pn; };
struct Gemm { const bf16_t* A; const bf16_t* Bt; int M, N, K; };

struct ListOrder {
    int n, G, c, mode, nN;
    __device__ __forceinline__ bool next(int i, Unit& u) const {
        const int L = i * G + c; if (L >= n) return false;
        if (mode == 0) { u.pm = L / nN; u.pn = L - u.pm * nN; }
        else if (mode == 1) {
            if (L < 544) { const int nn = L / 272, rem = L - nn * 272; u.pm = nn * 68 + (rem >> 2); u.pn = nn * 4 + (rem & 3); }
            else { const int Lp = L - 544, nn = 2 + Lp / 68; u.pm = nn * 68 + Lp % 68; u.pn = 8 + (nn - 2); }
        } else if (mode == 4) { const int nn = L / 272, rem = L - nn * 272; u.pm = rem >> 2; u.pn = nn * 4 + (rem & 3); }
        else if (mode == 3) { const int q = L >> 2; u.pm = (q >> 4) * 17 + (q & 15) + 1; u.pn = L & 3; }
        else { const int nn = L / 272, rem = L - nn * 272; u.pm = nn * 68 + (rem >> 2); u.pn = nn * 4 + (rem & 3); }
        return true;
    }
    __device__ __forceinline__ void a_ready(const Unit&) const {}
    __device__ __forceinline__ void done(const Unit&) const {}
};
template <class F> struct EpiT {
    static constexpr bool PERM = true, AFTER_DRAIN = false;
    F f;
    __device__ __forceinline__ void operator()(const f32x4 (&acc)[2][2][4][2], const Unit& u, int wr, int wc, int fr, int fq) const {
#pragma unroll
        for (int ai = 0; ai < 2; ++ai)
#pragma unroll
            for (int m = 0; m < 4; ++m)
#pragma unroll
                for (int bj = 0; bj < 2; ++bj) f(u, ai * 128 + wr * 64 + m * 16 + fr, bj * 128 + wc * 32 + 8 * fq, acc[ai][bj][m][0], acc[ai][bj][m][1]);
    }
};
template <class Epi, class Sched, bool ALIGN_EPI = false, bool SP2 = false>
__device__ __forceinline__ void gemm_phase(PG8_LAS unsigned char* lds, const Gemm g, const Sched& S, const Epi& E) {
    const int tid = threadIdx.x, wid = __builtin_amdgcn_readfirstlane(tid >> 6), lane = tid & 63, wr = wid >> 2, wc = wid & 3, fr = lane & 15, fq = lane >> 4;
    const int K = g.K, nt = K / BK;
    unsigned voffA[2], voffB[2];
#pragma unroll
    for (int i = 0; i < 2; ++i) { int R, C; stage_rc(tid * 16 + i * 8192, R, C); const int Rb = Epi::PERM ? ((R & ~31) + perm32(R & 31)) : R;
        voffA[i] = (unsigned)(R * K + C) * 2u; voffB[i] = (unsigned)(Rb * K + C) * 2u; }
    const size_t kstep = (size_t)(BK * 2);
    const size_t hstep = (size_t)HALF * K * 2;
    const size_t tstep = 2 * hstep;
    const unsigned ldsw = (unsigned)wid * 1024u;
    const int aoff = lds_byte(wr * 64 + fr, fq * 8), boff = lds_byte(wc * 32 + fr, fq * 8);
#define PG8_SA(b, h) (((b) * 2 + (h)) * HTB)
#define PG8_SB(b, h) ((4 + (b) * 2 + (h)) * HTB)
#define PG8_STAGE(bufoff, gbase, voff) do { _Pragma("unroll") for (int _i = 0; _i < 2; ++_i) \
        __builtin_amdgcn_global_load_lds((const unsigned*)((const char*)(gbase) + (voff)[_i]), (PG8_LAS unsigned*)(lds + (bufoff) + ldsw + _i * 8192), 16, 0, 0); } while (0)
#define PG8_LDA(dst, b, h) do { _Pragma("unroll") for (int m = 0; m < 4; ++m) _Pragma("unroll") for (int k = 0; k < 2; ++k) dst[m][k] = *(const PG8_LAS bf16x8*)(lds + PG8_SA(b, h) + aoff + m * 2048 + k * 1024); } while (0)
#define PG8_LDB(dst, b, h) do { _Pragma("unroll") for (int n = 0; n < 2; ++n) _Pragma("unroll") for (int k = 0; k < 2; ++k) dst[n][k] = *(const PG8_LAS bf16x8*)(lds + PG8_SB(b, h) + boff + n * 2048 + k * 1024); } while (0)
#define PG8_MMA(ai, bj, At, Bt) do { __builtin_amdgcn_s_setprio(1); _Pragma("unroll") for (int m = 0; m < 4; ++m) _Pragma("unroll") for (int n = 0; n < 2; ++n) _Pragma("unroll") for (int k = 0; k < 2; ++k) \
        acc[ai][bj][m][n] = __builtin_amdgcn_mfma_f32_16x16x32_bf16(Bt[n][k], At[m][k], acc[ai][bj][m][n], 0, 0, 0); __builtin_amdgcn_s_setprio(0); } while (0)
#define PG8_WAIT_V(n) asm volatile("s_waitcnt vmcnt(" #n ")" ::: "memory")
#define PG8_WAIT_L(n) asm volatile("s_waitcnt lgkmcnt(" #n ")" ::: "memory")
#define PG8_BAR __builtin_amdgcn_s_barrier()
#define PG8_SCHED __builtin_amdgcn_sched_barrier(0)
    Unit cur, nxt; int ui = 0;
    if (!S.next(0, cur)) return;
    f32x4 acc[2][2][4][2];
#pragma unroll
    for (int a = 0; a < 2; ++a)
#pragma unroll
        for (int b = 0; b < 2; ++b)
#pragma unroll
            for (int m = 0; m < 4; ++m)
#pragma unroll
                for (int n = 0; n < 2; ++n) acc[a][b][m][n] = (f32x4){0.f, 0.f, 0.f, 0.f};
    bf16x8 At[4][2], B0[2][2], B1[2][2];
    const char* cA = (const char*)g.A + (size_t)cur.pm * tstep; const char* cB = (const char*)g.Bt + (size_t)cur.pn * tstep;
    S.a_ready(cur);
    if constexpr (SP2) {
        PG8_STAGE(PG8_SB(0, 0), cB, voffB); PG8_STAGE(PG8_SB(0, 1), cB + hstep, voffB); PG8_STAGE(PG8_SA(0, 0), cA, voffA); PG8_STAGE(PG8_SA(0, 1), cA + hstep, voffA);
        if (wr == 1) PG8_BAR;
        PG8_WAIT_V(2); PG8_BAR;
        PG8_STAGE(PG8_SB(1, 0), cB + kstep, voffB); PG8_STAGE(PG8_SA(1, 0), cA + kstep, voffA); PG8_STAGE(PG8_SB(1, 1), cB + hstep + kstep, voffB);
        PG8_WAIT_V(6); PG8_BAR;
    } else {
        PG8_STAGE(PG8_SB(0, 0), cB, voffB); PG8_STAGE(PG8_SA(0, 0), cA, voffA); PG8_STAGE(PG8_SB(0, 1), cB + hstep, voffB); PG8_STAGE(PG8_SA(0, 1), cA + hstep, voffA);
        if (wr == 1) PG8_BAR;
        PG8_WAIT_V(4); PG8_BAR;
        PG8_STAGE(PG8_SB(1, 0), cB + kstep, voffB); PG8_STAGE(PG8_SA(1, 0), cA + kstep, voffA); PG8_STAGE(PG8_SB(1, 1), cB + hstep + kstep, voffB);
        PG8_WAIT_V(6); PG8_BAR;
    }
    for (;;) {
        const bool has_next = S.next(ui + 1, nxt);
        const char* nA = has_next ? (const char*)g.A + (size_t)nxt.pm * tstep : cA; const char* nB = has_next ? (const char*)g.Bt + (size_t)nxt.pn * tstep : cB;
        for (int t = 0; t < nt; t += 2) {
            const bool last = (t == nt - 2);
            const char* a1 = cA + (size_t)(t + 1) * kstep;
            const char* a2 = last ? nA : cA + (size_t)(t + 2) * kstep; const char* b2 = last ? nB : cB + (size_t)(t + 2) * kstep;
            const char* a3 = a2 + kstep; const char* b3 = b2 + kstep;
            if (last && has_next) S.a_ready(nxt);
            if constexpr (SP2) {
            PG8_LDB(B0, 0, 0); PG8_LDB(B1, 0, 1); PG8_SCHED; PG8_LDA(At, 0, 0); PG8_STAGE(PG8_SA(1, 1), a1 + hstep, voffA);
            PG8_WAIT_V(8); PG8_WAIT_L(0); PG8_BAR; PG8_MMA(0, 0, At, B0); PG8_MMA(0, 1, At, B1); PG8_BAR; PG8_SCHED;
            PG8_LDA(At, 0, 1); PG8_STAGE(PG8_SB(0, 0), b2, voffB); PG8_STAGE(PG8_SB(0, 1), b2 + hstep, voffB); PG8_STAGE(PG8_SA(0, 0), a2, voffA);
            PG8_WAIT_V(8); PG8_WAIT_L(0); PG8_BAR; PG8_MMA(1, 0, At, B0); PG8_MMA(1, 1, At, B1); PG8_BAR; PG8_SCHED;
            PG8_LDB(B0, 1, 0); PG8_LDB(B1, 1, 1); PG8_SCHED; PG8_LDA(At, 1, 0); PG8_STAGE(PG8_SA(0, 1), a2 + hstep, voffA);
            PG8_WAIT_V(8); PG8_WAIT_L(0); PG8_BAR; PG8_MMA(0, 0, At, B0); PG8_MMA(0, 1, At, B1); PG8_BAR; PG8_SCHED;
            PG8_LDA(At, 1, 1); PG8_STAGE(PG8_SB(1, 0), b3, voffB); PG8_STAGE(PG8_SB(1, 1), b3 + hstep, voffB); PG8_STAGE(PG8_SA(1, 0), a3, voffA);
            PG8_WAIT_V(8); PG8_WAIT_L(0); PG8_BAR; PG8_MMA(1, 0, At, B0); PG8_MMA(1, 1, At, B1); PG8_BAR; PG8_SCHED;
            } else {
            PG8_LDB(B0, 0, 0); PG8_SCHED; PG8_LDA(At, 0, 0); PG8_STAGE(PG8_SA(1, 1), a1 + hstep, voffA);
            PG8_WAIT_L(8); PG8_BAR; PG8_WAIT_L(0); PG8_MMA(0, 0, At, B0); PG8_BAR; PG8_SCHED;
            PG8_LDB(B1, 0, 1); PG8_STAGE(PG8_SB(0, 0), b2, voffB);
            PG8_BAR; PG8_WAIT_L(0); PG8_MMA(0, 1, At, B1); PG8_BAR;
            PG8_LDA(At, 0, 1); PG8_STAGE(PG8_SA(0, 0), a2, voffA);
            PG8_BAR; PG8_WAIT_L(0); PG8_MMA(1, 0, At, B0); PG8_BAR; PG8_SCHED;
            PG8_STAGE(PG8_SB(0, 1), b2 + hstep, voffB);
            PG8_WAIT_V(6); PG8_BAR; PG8_MMA(1, 1, At, B1); PG8_BAR;
            PG8_LDB(B0, 1, 0); PG8_SCHED; PG8_LDA(At, 1, 0); PG8_STAGE(PG8_SA(0, 1), a2 + hstep, voffA);
            PG8_WAIT_L(8); PG8_BAR; PG8_WAIT_L(0); PG8_MMA(0, 0, At, B0); PG8_BAR; PG8_SCHED;
            PG8_LDB(B1, 1, 1); PG8_STAGE(PG8_SB(1, 0), b3, voffB);
            PG8_BAR; PG8_WAIT_L(0); PG8_MMA(0, 1, At, B1); PG8_BAR;
            PG8_LDA(At, 1, 1); PG8_STAGE(PG8_SA(1, 0), a3, voffA);
            PG8_BAR; PG8_WAIT_L(0); PG8_MMA(1, 0, At, B0); PG8_BAR; PG8_SCHED;
            PG8_STAGE(PG8_SB(1, 1), b3 + hstep, voffB);
            PG8_WAIT_V(6); PG8_BAR; PG8_MMA(1, 1, At, B1); PG8_BAR;
            }
        }
        if constexpr (ALIGN_EPI) { if (wr == 0) PG8_BAR; }
        if constexpr (!Epi::AFTER_DRAIN) { E(acc, cur, wr, wc, fr, fq); S.done(cur); }
        if (!has_next) break;
#pragma unroll
        for (int a = 0; a < 2; ++a)
#pragma unroll
            for (int b = 0; b < 2; ++b)
#pragma unroll
                for (int m = 0; m < 4; ++m)
#pragma unroll
                    for (int n = 0; n < 2; ++n) acc[a][b][m][n] = (f32x4){0.f, 0.f, 0.f, 0.f};
        cur = nxt; cA = nA; cB = nB; ++ui;
        if constexpr (ALIGN_EPI) { if (wr == 1) PG8_BAR; }
    }
    PG8_WAIT_V(0);
    if constexpr (!ALIGN_EPI) { if (wr == 0) PG8_BAR; }
    PG8_BAR;
    if constexpr (Epi::AFTER_DRAIN) { E.fused(acc, cur, wr, wc, fr, fq, lds, wid, lane); S.done(cur); }
#undef PG8_SA
#undef PG8_SB
#undef PG8_STAGE
#undef PG8_LDA
#undef PG8_LDB
#undef PG8_MMA
#undef PG8_WAIT_V
#undef PG8_WAIT_L
#undef PG8_BAR
#undef PG8_SCHED
}
}

constexpr int NB = 4, SEQ = 4096, CTXL = 256, TB = SEQ + CTXL  , NT = NB * TB  , D = 1024, NMT = NT / 256  ;
constexpr int NWAVES = 8, NTHR = 512, GRID = 256;
constexpr size_t MiB = 1u << 20;
constexpr size_t OFF_MOD = 0, OFF_S5A = 256 * 1024, OFF_BAR = 512 * 1024, OFF_BB = 1 * MiB, OFF_L2T = 2 * MiB, OFF_CTX = 3 * MiB, OFF_WT = 7 * MiB, OFF_R0 = 18 * MiB, RSZ = 34 * MiB;
constexpr size_t WS_NEED = OFF_R0 + 7 * RSZ;
constexpr int LDS_BYTES = 147456;

typedef unsigned short bf16;
typedef float f32x4 __attribute__((ext_vector_type(4)));
typedef short bf16x8 __attribute__((ext_vector_type(8)));
typedef unsigned u32x4 __attribute__((ext_vector_type(4)));
typedef unsigned u32x2 __attribute__((ext_vector_type(2)));

__device__ __forceinline__ float bf2f(unsigned v) { return __builtin_bit_cast(float, v << 16); }
__device__ __forceinline__ unsigned f2bf(float f) { unsigned u = __builtin_bit_cast(unsigned, f); return (u + 0x7fffu + ((u >> 16) & 1u)) >> 16; }
__device__ __forceinline__ unsigned f2bf_hw(float f) { unsigned r; asm("v_cvt_pk_bf16_f32 %0, %1, %1" : "=v"(r) : "v"(f)); return r & 0xffffu; }
__device__ __forceinline__ unsigned pk2(float lo, float hi) { unsigned r; asm("v_cvt_pk_bf16_f32 %0, %1, %2" : "=v"(r) : "v"(lo), "v"(hi)); return r; }
__device__ __forceinline__ float lo_bf(unsigned w) { return __builtin_bit_cast(float, w << 16); }
__device__ __forceinline__ float hi_bf(unsigned w) { return __builtin_bit_cast(float, w & 0xffff0000u); }
__device__ __forceinline__ void store8(bf16* p, f32x4 a, f32x4 b) { u32x4 w; w.x = pk2(a.x, a.y); w.y = pk2(a.z, a.w); w.z = pk2(b.x, b.y); w.w = pk2(b.z, b.w); *(u32x4*)p = w; }
__device__ __forceinline__ float sigm(float x) { return __builtin_amdgcn_rcpf(1.f + __expf(-x)); }
__device__ __forceinline__ float tanh_fast(float x) { return 1.f - 2.f * __builtin_amdgcn_rcpf(1.f + __expf(2.f * x)); }
__device__ __forceinline__ float silu(float x) { return x * __builtin_amdgcn_rcpf(1.f + __expf(-x)); }
__device__ __forceinline__ unsigned cvt_pk_bf16(float lo, float hi) { unsigned r; asm("v_cvt_pk_bf16_f32 %0, %1, %2" : "=v"(r) : "v"(lo), "v"(hi)); return r; }
__device__ __forceinline__ bf16x8 pack8(const float (&f)[8]) { u32x4 h; h.x = pk2(f[0], f[1]); h.y = pk2(f[2], f[3]); h.z = pk2(f[4], f[5]); h.w = pk2(f[6], f[7]); return __builtin_bit_cast(bf16x8, h); }
__device__ __forceinline__ void split8(const float (&f)[8], bf16x8& hi, bf16x8& lo) {
    u32x4 h, l;
#pragma unroll
    for (int i = 0; i < 4; ++i) { const unsigned hw = cvt_pk_bf16(f[2 * i], f[2 * i + 1]); h[i] = hw; l[i] = cvt_pk_bf16(f[2 * i] - lo_bf(hw), f[2 * i + 1] - hi_bf(hw)); }
    hi = __builtin_bit_cast(bf16x8, h); lo = __builtin_bit_cast(bf16x8, l);
}
template <int CTRL> __device__ __forceinline__ float dppf(float x) { return __builtin_bit_cast(float, __builtin_amdgcn_update_dpp(0, __builtin_bit_cast(int, x), CTRL, 0xF, 0xF, false)); }
__device__ __forceinline__ float allred16(float x) { x += dppf<0x128>(x); x += dppf<0x124>(x); x += dppf<0x122>(x); x += dppf<0x121>(x); return x; }
__device__ __forceinline__ float wave_sum(float v) {
    v = allred16(v);
    const float s0 = __builtin_bit_cast(float, __builtin_amdgcn_readlane(__builtin_bit_cast(int, v), 0)), s1 = __builtin_bit_cast(float, __builtin_amdgcn_readlane(__builtin_bit_cast(int, v), 16));
    const float s2 = __builtin_bit_cast(float, __builtin_amdgcn_readlane(__builtin_bit_cast(int, v), 32)), s3 = __builtin_bit_cast(float, __builtin_amdgcn_readlane(__builtin_bit_cast(int, v), 48));
    return (s0 + s1) + (s2 + s3);
}
__device__ __forceinline__ int tokof(int s, int q) { return s == 0 ? q : (q < CTXL ? (CTXL - 1 - q) : (TB + CTXL - 1 - q)); }

struct Args { const float* in[38]; float* out; unsigned char* ws; int ph_lo, ph_hi; };

struct Fr {
    const Args* a; unsigned char* lds; unsigned char* ws; int tid, lane, wave, gw;
    __device__ __forceinline__ bf16* R(int i) const { return (bf16*)(ws + OFF_R0 + (size_t)i * RSZ); }
    __device__ __forceinline__ float* mod(int l) const { return (float*)(ws + OFF_MOD) + l * 5 * 3072; }
    __device__ __forceinline__ bf16* WT() const { return (bf16*)(ws + OFF_WT); }
    __device__ __forceinline__ float* ctxbuf() const { return (float*)(ws + OFF_CTX); }
};
__device__ __forceinline__ const float* xrow(const Fr& F, int l, int m) {
    const int b = m / TB, t = m - b * TB;
    if (t < CTXL) return (l == 0 ? F.a->in[2] : F.ctxbuf()) + (size_t)(b * CTXL + t) * D;
    return (l == 0 ? F.a->in[0] : F.a->out) + (size_t)(b * SEQ + t - CTXL) * D;
}

struct FRkv {
    bf16* o0; bf16* o1; bf16* lm;
    __device__ __forceinline__ void operator()(const pg8::Unit& u, int rl, int cl, f32x4 v0, f32x4 v1) const {
        const int nn = u.pm / NMT, pm = u.pm - nn * NMT; const size_t row = (size_t)pm * 256 + rl;
        if (nn < 2) { const int col = (u.pn - nn * 4) * 256 + cl; store8((nn ? o1 : o0) + row * D + col, v0, v1); }
        else if (cl < 128) {
            if (nn == 2) { v0.x = tanh_fast(v0.x); v0.y = tanh_fast(v0.y); v0.z = tanh_fast(v0.z); v0.w = tanh_fast(v0.w); v1.x = tanh_fast(v1.x); v1.y = tanh_fast(v1.y); v1.z = tanh_fast(v1.z); v1.w = tanh_fast(v1.w); }
            store8(lm + row * 256 + (nn - 2) * 128 + cl, v0, v1);
        }
    }
};
struct FResid {
    const float* xo; const float* co; float* xn; float* cn; const float* modl;
    __device__ __forceinline__ void operator()(const pg8::Unit& u, int rl, int cl, f32x4 v0, f32x4 v1) const {
        const int b = u.pm / 17, j = u.pm - 17 * b, col = u.pn * 256 + cl;
        const float* src; float* dst; const float* gate;
        if (j == 0) { const size_t off = (size_t)(b * CTXL + rl) * D + col; src = co + off; dst = cn + off; gate = modl + 4 * 3072 + 2048 + col; }
        else { const size_t off = (size_t)(b * SEQ + (j - 1) * 256 + rl) * D + col; src = xo + off; dst = xn + off; gate = modl + b * 3072 + 2048 + col; }
        const f32x4 a0 = *(const f32x4*)src, a1 = *(const f32x4*)(src + 4), g0 = *(const f32x4*)gate, g1 = *(const f32x4*)(gate + 4);
        *(f32x4*)dst = a0 + g0 * v0; *(f32x4*)(dst + 4) = a1 + g1 * v1;
    }
};
struct FNaIn {
    bf16* q; bf16* k; bf16* vt; bf16* z;
    __device__ __forceinline__ void operator()(const pg8::Unit& u, int rl, int cl, f32x4 v0, f32x4 v1) const {
        const int sel = u.pn >> 2, col = (u.pn & 3) * 256 + cl; const size_t row = (size_t)u.pm * 256 + rl;
        if (sel == 2) {
            const int b = u.pm / 17, t = (u.pm - 17 * b) * 256 + rl, head = col >> 6, d = col & 63;
            bf16* p = vt + ((size_t)(b * 16 + head) * 64 + d) * TB + t;
            const unsigned w0 = pk2(v0.x, v0.y), w1 = pk2(v0.z, v0.w), w2 = pk2(v1.x, v1.y), w3 = pk2(v1.z, v1.w);
            p[0] = (bf16)w0; p[TB] = (bf16)(w0 >> 16); p[2 * TB] = (bf16)w1; p[3 * TB] = (bf16)(w1 >> 16);
            p[4 * TB] = (bf16)w2; p[5 * TB] = (bf16)(w2 >> 16); p[6 * TB] = (bf16)w3; p[7 * TB] = (bf16)(w3 >> 16);
        } else { bf16* o = q + (size_t)sel * (RSZ / 2); store8(o + row * D + col, v0, v1); }
    }
};
struct FS5In {
    bf16* uo; bf16* z;
    __device__ __forceinline__ void operator()(const pg8::Unit& u, int rl, int cl, f32x4 v0, f32x4 v1) const {
        const size_t row = (size_t)u.pm * 256 + rl;
        if (u.pn < 4) store8(uo + row * D + u.pn * 256 + cl, v0, v1);
        else store8(z + row * D + (u.pn - 4) * 256 + cl, v0, v1);
    }
};
struct FGlu {
    const bf16* y; const bf16* z; const float* bias; bf16* o;
    __device__ __forceinline__ void operator()(const pg8::Unit& u, int rl, int cl, f32x4 v0, f32x4 v1) const {
        const int col = u.pn * 256 + cl; const size_t off = ((size_t)u.pm * 256 + rl) * D + col;
        const u32x4 yw = *(const u32x4*)(y + off), zw = *(const u32x4*)(z + off);
        const f32x4 b0 = *(const f32x4*)(bias + col), b1 = *(const f32x4*)(bias + col + 4);
        f32x4 r0, r1;
        r0.x = lo_bf(yw.x) * sigm(v0.x + b0.x) * silu(lo_bf(zw.x)); r0.y = hi_bf(yw.x) * sigm(v0.y + b0.y) * silu(hi_bf(zw.x));
        r0.z = lo_bf(yw.y) * sigm(v0.z + b0.z) * silu(lo_bf(zw.y)); r0.w = hi_bf(yw.y) * sigm(v0.w + b0.w) * silu(hi_bf(zw.y));
        r1.x = lo_bf(yw.z) * sigm(v1.x + b1.x) * silu(lo_bf(zw.z)); r1.y = hi_bf(yw.z) * sigm(v1.y + b1.y) * silu(hi_bf(zw.z));
        r1.z = lo_bf(yw.w) * sigm(v1.z + b1.z) * silu(lo_bf(zw.w)); r1.w = hi_bf(yw.w) * sigm(v1.w + b1.w) * silu(hi_bf(zw.w));
        store8(o + off, r0, r1);
    }
};

template <class F> __device__ __forceinline__ void run_gemm(const Fr& Fm, const bf16* A, const bf16* Bt, int K, int nunits, int mode, int nN, const F& f) {
    pg8::Gemm g{A, Bt, 0, 0, K}; const int bx = (int)blockIdx.x, cxcd = (gridDim.x == 256) ? (bx & 7) * 32 + (bx >> 3) : bx;
    pg8::ListOrder S{nunits, (int)gridDim.x, cxcd, mode, nN}; pg8::EpiT<F> E{f};
    pg8::gemm_phase<pg8::EpiT<F>, pg8::ListOrder, true, true>((PG8_LAS unsigned char*)Fm.lds, g, S, E);
}

__device__ __forceinline__ void transpose_item(const float* W, int K, int N, bf16* WT, int row_off, float* scr, int item, int lane) {
    const int nblk = N / 32, kb = item / nblk, nb = item % nblk, k0 = 64 * kb, n0 = 32 * nb;
    f32x4 v[8];
#pragma unroll
    for (int i = 0; i < 8; ++i) v[i] = *(const f32x4*)(W + (size_t)(k0 + 8 * i + (lane >> 3)) * N + n0 + 4 * (lane & 7));
#pragma unroll
    for (int i = 0; i < 8; ++i) { float* d = scr + (8 * i + (lane >> 3)) * 33 + 4 * (lane & 7); d[0] = v[i].x; d[1] = v[i].y; d[2] = v[i].z; d[3] = v[i].w; }
    asm volatile("s_waitcnt lgkmcnt(0)" ::: "memory");
    const int c = lane & 7;
#pragma unroll
    for (int j = 0; j < 4; ++j) { const int n = (lane >> 3) + 8 * j; const float* s = scr + (8 * c) * 33 + n;
        u32x4 o; o.x = pk2(s[0 * 33], s[1 * 33]); o.y = pk2(s[2 * 33], s[3 * 33]); o.z = pk2(s[4 * 33], s[5 * 33]); o.w = pk2(s[6 * 33], s[7 * 33]);
        *(u32x4*)(WT + (size_t)(row_off + n0 + n) * K + k0 + 8 * c) = o; }
    asm volatile("s_waitcnt lgkmcnt(0)" ::: "memory");
}
__device__ __forceinline__ void conv_mat(const Fr& F, const float* W, int K, int N, bf16* WT, int row_off) {
    float* scr = (float*)(F.lds + F.wave * 16384);
    const int nitems = (K / 64) * (N / 32);
    for (int it = F.gw; it < nitems; it += GRID * NWAVES) transpose_item(W, K, N, WT, row_off, scr, it, F.lane);
}
__device__ __forceinline__ void conv_rwkv(const Fr& F, int j) {
    const float* rkvg = F.a->in[8] + (size_t)j * 4 * D * D;
    conv_mat(F, rkvg, D, D, F.WT(), 0); conv_mat(F, rkvg + (size_t)D * D, D, D, F.WT(), 1024);
    conv_mat(F, rkvg + (size_t)2 * D * D, D, D, F.WT(), 2560); conv_mat(F, rkvg + (size_t)3 * D * D, D, D, F.WT(), 3584);
    for (int s = 0; s < 2; ++s) {
        conv_mat(F, F.a->in[10] + (size_t)(j * 2 + s) * D * 64, D, 64, F.WT(), 2048 + 64 * s);
        conv_mat(F, F.a->in[13] + (size_t)(j * 2 + s) * D * 64, D, 64, F.WT(), 2304 + 64 * s);
        conv_mat(F, F.a->in[11] + (size_t)(j * 2 + s) * 64 * D, 64, D, (bf16*)(F.ws + OFF_L2T) + (size_t)s * D * 64, 0);
        conv_mat(F, F.a->in[14] + (size_t)(j * 2 + s) * 64 * D, 64, D, (bf16*)(F.ws + OFF_L2T) + (size_t)(2 + s) * D * 64, 0);
    }
    conv_mat(F, F.a->in[20] + (size_t)j * D * D, D, D, F.WT(), 4608);
}

__device__ __forceinline__ void phase_mod(const Fr& F) {
    float* sc = (float*)F.lds;
    float* red = sc + 5120;
    for (int i = F.tid; i < 5120; i += NTHR) { const int j = i >> 10, k = i & 1023; const float v = j < 4 ? F.a->in[1][j * D + k] : F.a->in[3][k]; sc[i] = silu(v); }
    __syncthreads();
    for (int task = blockIdx.x; task < 192; task += gridDim.x) {
        const int l = task / 48, n0 = (task - l * 48) * 64;
        const float* wm = F.a->in[5] + (size_t)l * D * 3072 + n0 + F.lane;
        float acc[5] = {0.f, 0.f, 0.f, 0.f, 0.f};
#pragma unroll 16
        for (int kk = 0; kk < 128; ++kk) { const int k = F.wave * 128 + kk; const float w = wm[(size_t)k * 3072];
#pragma unroll
            for (int j = 0; j < 5; ++j) acc[j] += sc[j * 1024 + k] * w; }
#pragma unroll
        for (int j = 0; j < 5; ++j) red[(F.wave * 5 + j) * 64 + F.lane] = acc[j];
        __syncthreads();
        if (F.tid < 320) { const int j = F.tid >> 6, ln = F.tid & 63; float s = F.a->in[6][l * 3072 + n0 + ln];
            for (int w = 0; w < 8; ++w) s += red[(w * 5 + j) * 64 + ln];
            F.mod(l)[j * 3072 + n0 + ln] = s; }
        __syncthreads();
    }
}

template <int NR> __device__ __forceinline__ void load_rows(const Fr& F, int l, int m0, int mlo, int mhi, f32x4 (&h)[NR][4]) {
#pragma unroll
    for (int r = 0; r < NR; ++r) {
        const int m = m0 + r; const bool valid = m >= mlo && m < mhi;
        const f32x4* xr = (const f32x4*)xrow(F, l, valid ? m : mlo) + F.lane;
#pragma unroll
        for (int j = 0; j < 4; ++j) h[r][j] = valid ? xr[64 * j] : (f32x4){0.f, 0.f, 0.f, 0.f};
    }
}
template <int NR> __device__ __forceinline__ void norm_rows(const Fr& F, int l, int m0, f32x4 (&h)[NR][4]) {
    const int b = m0 / TB, t = m0 - b * TB; const float* md = F.mod(l) + (t < CTXL ? 4 : b) * 3072;
    f32x4 gs[4], sh[4];
#pragma unroll
    for (int j = 0; j < 4; ++j) { const f32x4 g = ((const f32x4*)(F.a->in[4] + l * D) + F.lane)[64 * j], sc = ((const f32x4*)(md + 1024) + F.lane)[64 * j]; gs[j] = g * (sc + 1.f); sh[j] = ((const f32x4*)md + F.lane)[64 * j]; }
    float ss[NR];
#pragma unroll
    for (int r = 0; r < NR; ++r) { ss[r] = 0.f;
#pragma unroll
        for (int j = 0; j < 4; ++j) ss[r] += (h[r][j].x * h[r][j].x + h[r][j].y * h[r][j].y) + (h[r][j].z * h[r][j].z + h[r][j].w * h[r][j].w); }
#pragma unroll
    for (int r = 0; r < NR; ++r) { const float rstd = 1.f / sqrtf(wave_sum(ss[r]) * (1.f / D) + 1e-6f);
#pragma unroll
        for (int j = 0; j < 4; ++j) h[r][j] = (h[r][j] * rstd) * gs[j] + sh[j]; }
}
__device__ __forceinline__ void store_row_bf16(bf16* orow, int lane, const f32x4 (&v)[4]) {
    u32x2* o = (u32x2*)orow + lane;
#pragma unroll
    for (int j = 0; j < 4; ++j) { u32x2 w; w.x = pk2(v[j].x, v[j].y); w.y = pk2(v[j].z, v[j].w); o[64 * j] = w; }
}
__device__ __forceinline__ void phase_norm_plain(const Fr& F, int l) {
    for (int run = F.gw; run < NT / 4; run += GRID * NWAVES) {
        const int m0 = run * 4; f32x4 h[4][4];
        load_rows<4>(F, l, m0, 0, NT, h); norm_rows<4>(F, l, m0, h);
#pragma unroll
        for (int r = 0; r < 4; ++r) store_row_bf16(F.R(0) + (size_t)(m0 + r) * D, F.lane, h[r]);
    }
}
__device__ __forceinline__ void phase_norm_mix(const Fr& F, int l, int jr, int nmix, int n0, int n1, int n2, int n3) {
    const int nidx[4] = {n0, n1, n2, n3};
    for (int run = F.gw; run < NT / 4; run += GRID * NWAVES) {
        const int m0 = run * 4, b = m0 / TB, t0 = m0 - b * TB, seg_lo = b * TB + (t0 < CTXL ? 0 : CTXL), seg_hi = b * TB + (t0 < CTXL ? CTXL : TB);
        f32x4 h[6][4];
        load_rows<6>(F, l, m0 - 1, seg_lo, seg_hi, h); norm_rows<6>(F, l, m0, h);
        if (m0 - 1 < seg_lo) {
#pragma unroll
            for (int j = 0; j < 4; ++j) h[0][j] = (f32x4){0.f, 0.f, 0.f, 0.f}; }
        if (m0 + 4 >= seg_hi) {
#pragma unroll
            for (int j = 0; j < 4; ++j) h[5][j] = (f32x4){0.f, 0.f, 0.f, 0.f}; }
#pragma unroll
        for (int q = 0; q < 4; ++q) if (q < nmix) {
            f32x4 mu[4];
#pragma unroll
            for (int j = 0; j < 4; ++j) mu[j] = ((const f32x4*)(F.a->in[7] + (size_t)(jr * 6 + nidx[q]) * D) + F.lane)[64 * j];
#pragma unroll
            for (int r = 0; r < 4; ++r) { f32x4 o[4];
#pragma unroll
                for (int j = 0; j < 4; ++j) o[j] = h[r + 1][j] + ((h[r][j] + h[r + 2][j]) * 0.5f - h[r + 1][j]) * mu[j];
                store_row_bf16(F.R(q) + (size_t)(m0 + r) * D, F.lane, o); }
        }
    }
}

typedef float f32x2 __attribute__((ext_vector_type(2)));
#define LDS_BAR() asm volatile("s_waitcnt lgkmcnt(0)\n\ts_barrier" ::: "memory")
__device__ __forceinline__ void phase_rwkv_scan(const Fr& F, int jr) {
    float* Wv = (float*)F.lds; float* KK = Wv + 4096; float* Bv = KK + 4096; float* KD = Bv + 4096; float* Rr = KD + 4096; float* Av = Rr + 4096;
    float* Vv = Av + 8192; float* Yp = Av;
    const bf16* Rb = F.R(4); const bf16* Kb = F.R(5); const bf16* Vb = F.R(2); const bf16* LM = F.R(6);
    const bf16* L2T = (const bf16*)(F.ws + OFF_L2T);
    const int lane = F.lane, wave = F.wave, tid = F.tid, l15 = lane & 15, lq = lane >> 4;
    const int bxs = (int)blockIdx.x, bxcd = (gridDim.x == 256) ? (bxs & 7) * 32 + (bxs >> 3) : bxs;
    for (int task = bxcd; task < 256; task += gridDim.x) {
        const int half = task & 1, h = (task >> 1) & 15, b = (task >> 5) & 3, s = task >> 7;
        bf16* Yb = F.R(s);
        const float* w0 = F.a->in[9] + (size_t)(jr * 2 + s) * D + h * 64; const float* a0 = F.a->in[12] + (size_t)(jr * 2 + s) * D + h * 64;
        const float* kkw = F.a->in[15] + (size_t)jr * D + h * 64; const float* kaw = F.a->in[16] + (size_t)jr * D + h * 64;
        f32x2 S01 = {0.f, 0.f}, S23 = {0.f, 0.f};
        const int ks = 4 * l15, rloc = 4 * wave + lq;
        const int pt = wave & 3, ht0 = (wave >> 2) * 2;
        const int p1 = pt * 16 + l15;
        const int p2 = tid >> 3, j8 = tid & 7, hk0 = 8 * j8;
        bf16x8 Bw[2][2], Ba[2][2]; float w0v[2], a0v[2];
#pragma unroll
        for (int hh = 0; hh < 2; ++hh) { const int hk = (ht0 + hh) * 16 + l15, e = h * 64 + hk; w0v[hh] = w0[hk]; a0v[hh] = a0[hk];
#pragma unroll
            for (int kst = 0; kst < 2; ++kst) { Bw[hh][kst] = *(const bf16x8*)(L2T + ((size_t)s * D + e) * 64 + 32 * kst + 8 * lq); Ba[hh][kst] = *(const bf16x8*)(L2T + ((size_t)(2 + s) * D + e) * 64 + 32 * kst + 8 * lq); } }
        float kkc[8], kac[8], rkc[8];
#pragma unroll
        for (int i = 0; i < 8; ++i) { kkc[i] = kkw[hk0 + i]; kac[i] = kaw[hk0 + i]; rkc[i] = F.a->in[17][(size_t)jr * D + h * 64 + hk0 + i]; }
        float* Bon = (float*)(F.ws + OFF_R0 + 6 * RSZ + 16 * MiB);
        bf16x8 Aw[2], Aa[2]; u32x4 kw, rw; u32x2 vw;
        {   const size_t row1 = (size_t)b * TB + tokof(s, p1), row2 = (size_t)b * TB + tokof(s, p2);
#pragma unroll
            for (int kst = 0; kst < 2; ++kst) { Aw[kst] = *(const bf16x8*)(LM + row1 * 256 + 64 * s + 32 * kst + 8 * lq); Aa[kst] = *(const bf16x8*)(LM + row1 * 256 + 128 + 64 * s + 32 * kst + 8 * lq); }
            kw = *(const u32x4*)(Kb + row2 * D + h * 64 + hk0); rw = *(const u32x4*)(Rb + row2 * D + h * 64 + hk0); vw = *(const u32x2*)(Vb + row2 * D + h * 64 + 32 * half + 4 * j8); }
        for (int chunk = 0; chunk < TB / 64; ++chunk) {
#pragma unroll
            for (int hh = 0; hh < 2; ++hh) {
                const int hk = (ht0 + hh) * 16 + l15;
                f32x4 cw = {0.f, 0.f, 0.f, 0.f}, ca = {0.f, 0.f, 0.f, 0.f};
#pragma unroll
                for (int kst = 0; kst < 2; ++kst) { cw = __builtin_amdgcn_mfma_f32_16x16x32_bf16(Aw[kst], Bw[hh][kst], cw, 0, 0, 0); ca = __builtin_amdgcn_mfma_f32_16x16x32_bf16(Aa[kst], Ba[hh][kst], ca, 0, 0, 0); }
#pragma unroll
                for (int reg = 0; reg < 4; ++reg) { const int pp = pt * 16 + lq * 4 + reg;
                    Wv[pp * 64 + hk] = __expf(-0.60653066f * sigm(w0v[hh] + cw[reg]));
                    Av[pp * 64 + hk] = sigm(a0v[hh] + ca[reg]); }
            }
            LDS_BAR();
            {
                const float kr[8] = {lo_bf(kw.x), hi_bf(kw.x), lo_bf(kw.y), hi_bf(kw.y), lo_bf(kw.z), hi_bf(kw.z), lo_bf(kw.w), hi_bf(kw.w)};
                const float rr[8] = {lo_bf(rw.x), hi_bf(rw.x), lo_bf(rw.y), hi_bf(rw.y), lo_bf(rw.z), hi_bf(rw.z), lo_bf(rw.w), hi_bf(rw.w)};
                float kq[8]; float ss = 0.f, bon = 0.f;
#pragma unroll
                for (int i = 0; i < 8; ++i) { kq[i] = kr[i] * kkc[i]; ss += kq[i] * kq[i]; bon += rr[i] * kr[i] * rkc[i]; }
                ss += dppf<0xB1>(ss); ss += dppf<0x4E>(ss); ss += dppf<0x141>(ss); bon += dppf<0xB1>(bon); bon += dppf<0x4E>(bon); bon += dppf<0x141>(bon);
                if (s == 0 && half == 0 && j8 == 0) Bon[((size_t)b * TB + tokof(s, chunk * 64 + p2)) * 16 + h] = bon;
                const float inv = 1.f / fmaxf(sqrtf(ss), 1e-12f);
                const f32x4 av0 = *(const f32x4*)(Av + p2 * 64 + hk0), av1 = *(const f32x4*)(Av + p2 * 64 + hk0 + 4);
                const float av[8] = {av0.x, av0.y, av0.z, av0.w, av1.x, av1.y, av1.z, av1.w};
                float o1[8], o2[8], o3[8];
#pragma unroll
                for (int i = 0; i < 8; ++i) { const float kkv = kq[i] * inv; o1[i] = kkv; o2[i] = kkv * av[i]; o3[i] = kr[i] * (1.f + (av[i] - 1.f) * kac[i]); }
                const int o = p2 * 64 + hk0;
                *(f32x4*)(KK + o) = (f32x4){o1[0], o1[1], o1[2], o1[3]}; *(f32x4*)(KK + o + 4) = (f32x4){o1[4], o1[5], o1[6], o1[7]};
                *(f32x4*)(Bv + o) = (f32x4){o2[0], o2[1], o2[2], o2[3]}; *(f32x4*)(Bv + o + 4) = (f32x4){o2[4], o2[5], o2[6], o2[7]};
                *(f32x4*)(KD + o) = (f32x4){o3[0], o3[1], o3[2], o3[3]}; *(f32x4*)(KD + o + 4) = (f32x4){o3[4], o3[5], o3[6], o3[7]};
                *(f32x4*)(Rr + o) = (f32x4){rr[0], rr[1], rr[2], rr[3]}; *(f32x4*)(Rr + o + 4) = (f32x4){rr[4], rr[5], rr[6], rr[7]};
                *(f32x4*)(Vv + p2 * 32 + 4 * j8) = (f32x4){lo_bf(vw.x), hi_bf(vw.x), lo_bf(vw.y), hi_bf(vw.y)};
            }
            if (chunk + 1 < TB / 64) {
                const size_t row1 = (size_t)b * TB + tokof(s, (chunk + 1) * 64 + p1), row2 = (size_t)b * TB + tokof(s, (chunk + 1) * 64 + p2);
#pragma unroll
                for (int kst = 0; kst < 2; ++kst) { Aw[kst] = *(const bf16x8*)(LM + row1 * 256 + 64 * s + 32 * kst + 8 * lq); Aa[kst] = *(const bf16x8*)(LM + row1 * 256 + 128 + 64 * s + 32 * kst + 8 * lq); }
                kw = *(const u32x4*)(Kb + row2 * D + h * 64 + hk0); rw = *(const u32x4*)(Rb + row2 * D + h * 64 + hk0); vw = *(const u32x2*)(Vb + row2 * D + h * 64 + 32 * half + 4 * j8);
            }
            LDS_BAR();
            {
                float* Ypw = Yp + wave * 1024;
                unsigned a1 = (unsigned)(size_t)(__attribute__((address_space(3))) float*)(Wv + ks), a2 = (unsigned)(size_t)(__attribute__((address_space(3))) float*)(Rr + ks),
                         a3 = (unsigned)(size_t)(__attribute__((address_space(3))) float*)(Vv + rloc), a4 = (unsigned)(size_t)(__attribute__((address_space(3))) float*)(Ypw + lane);
                asm volatile("" : "+v"(a1), "+v"(a2), "+v"(a3), "+v"(a4));
                typedef const __attribute__((address_space(3))) f32x4* lp4; typedef const __attribute__((address_space(3))) float* lp1; typedef __attribute__((address_space(3))) float* lw1;
                const lp4 PW = (lp4)a1, PR = (lp4)a2; const lp1 PV = (lp1)a3; const lw1 PY = (lw1)a4;
                f32x4 w4 = PW[0], k4 = PW[1024], b4 = PW[2048], d4 = PW[3072], r4 = PR[0];
                float vv = PV[0];
                for (int pg = 0; pg < 64; pg += 16) {
#pragma unroll
                    for (int pi = 0; pi < 16; ++pi) {
                        const int p = pg + pi, pn = p < 63 ? p + 1 : 63;
                        const f32x4 w4n = PW[pn * 16], k4n = PW[1024 + pn * 16], b4n = PW[2048 + pn * 16], d4n = PW[3072 + pn * 16], r4n = PR[pn * 16];
                        const float vvn = PV[pn * 32];
                        f32x2 t = S01 * k4.xy; t = S23 * k4.zw + t; float sa = t.x + t.y;
                        sa += dppf<0x128>(sa);
                        const f32x2 dv01 = d4.xy * vv, dv23 = d4.zw * vv;
                        sa += dppf<0x124>(sa);
                        const f32x2 e01 = S01 * w4.xy + dv01;
                        sa += dppf<0x122>(sa);
                        const f32x2 e23 = S23 * w4.zw + dv23;
                        sa += dppf<0x121>(sa);
                        S01 = e01 - b4.xy * sa; S23 = e23 - b4.zw * sa;
                        f32x2 u = S01 * r4.xy; u = S23 * r4.zw + u;
                        PY[pi * 64] = u.x + u.y;
                        w4 = w4n; k4 = k4n; b4 = b4n; d4 = d4n; r4 = r4n; vv = vvn;
                    }
                    asm volatile("s_waitcnt lgkmcnt(0)" ::: "memory");
                    {
                        const int j = lane >> 2, q = lane & 3; const float* yp = Ypw + j * 64 + q * 16;
                        const f32x4 a0 = *(const f32x4*)yp, a1 = *(const f32x4*)(yp + 4), a2 = *(const f32x4*)(yp + 8), a3 = *(const f32x4*)(yp + 12);
                        const f32x4 ssum = (a0 + a1) + (a2 + a3); const float yv = (ssum.x + ssum.y) + (ssum.z + ssum.w);
                        const size_t row = (size_t)b * TB + tokof(s, chunk * 64 + pg + j);
                        Yb[row * D + h * 64 + 32 * half + 4 * wave + q] = (bf16)f2bf(yv);
                    }
                    asm volatile("s_waitcnt lgkmcnt(0)" ::: "memory");
                }
            }
            LDS_BAR();
        }
        LDS_BAR();
    }
}

__device__ __forceinline__ void phase_rwkv_post(const Fr& F, int jr) {
    const float* lnw = F.a->in[18] + (size_t)jr * D; const float* lnb = F.a->in[19] + (size_t)jr * D;
    const float* Bon = (const float*)(F.ws + OFF_R0 + 6 * RSZ + 16 * MiB);
    for (int m = F.gw; m < NT; m += GRID * NWAVES) {
        const size_t base = (size_t)m * D;
        u32x2 ow[4];
#pragma unroll
        for (int j = 0; j < 4; ++j) {
            const int c = 256 * j + 4 * F.lane;
            const u32x2 y0 = *(const u32x2*)(F.R(0) + base + c), y1 = *(const u32x2*)(F.R(1) + base + c), vw = *(const u32x2*)(F.R(2) + base + c), gw = *(const u32x2*)(F.R(3) + base + c);
            const float bsum = Bon[(size_t)m * 16 + 4 * j + (F.lane >> 4)];
            float y[4] = {lo_bf(y0.x) + lo_bf(y1.x), hi_bf(y0.x) + hi_bf(y1.x), lo_bf(y0.y) + lo_bf(y1.y), hi_bf(y0.y) + hi_bf(y1.y)};
            const float v[4] = {lo_bf(vw.x), hi_bf(vw.x), lo_bf(vw.y), hi_bf(vw.y)}, g[4] = {lo_bf(gw.x), hi_bf(gw.x), lo_bf(gw.y), hi_bf(gw.y)};
            const f32x4 lw = *(const f32x4*)(lnw + c), lb = *(const f32x4*)(lnb + c);
            const float mean = allred16((y[0] + y[1]) + (y[2] + y[3])) * (1.f / 64.f);
            float q = 0.f;
#pragma unroll
            for (int i = 0; i < 4; ++i) { y[i] -= mean; q += y[i] * y[i]; }
            const float rstd = 1.f / sqrtf(allred16(q) * (1.f / 64.f) + 64e-5f);
            float o[4];
#pragma unroll
            for (int i = 0; i < 4; ++i) o[i] = (y[i] * rstd * lw[i] + lb[i] + bsum * v[i]) * silu(g[i]);
            ow[j].x = pk2(o[0], o[1]); ow[j].y = pk2(o[2], o[3]);
        }
#pragma unroll
        for (int j = 0; j < 4; ++j) *(u32x2*)(F.R(0) + base + 256 * j + 4 * F.lane) = ow[j];
    }
}

__device__ __forceinline__ void phase_na_qknorm(const Fr& F) {
    const float* qg = F.a->in[22]; const float* kg = F.a->in[23];
    const int d0 = 4 * (F.lane & 15);
    for (int m = F.gw; m < 2 * NT; m += GRID * NWAVES) {
        const int isk = m >= NT; bf16* p = F.R(1 + isk) + (size_t)(m - isk * NT) * D; const float* g = isk ? kg : qg; const float sc = isk ? 1.f : 0.125f;
#pragma unroll
        for (int j = 0; j < 4; ++j) {
            u32x2* pp = (u32x2*)(p + 256 * j + 4 * F.lane); const u32x2 w = *pp;
            float x[4] = {lo_bf(w.x), hi_bf(w.x), lo_bf(w.y), hi_bf(w.y)};
            const float ss = allred16((x[0] * x[0] + x[1] * x[1]) + (x[2] * x[2] + x[3] * x[3]));
            const float rstd = sc / sqrtf(ss * (1.f / 64.f) + 1e-6f);
            u32x2 o; o.x = pk2(x[0] * rstd * g[d0], x[1] * rstd * g[d0 + 1]); o.y = pk2(x[2] * rstd * g[d0 + 2], x[3] * rstd * g[d0 + 3]);
            *pp = o;
        }
    }
}
__device__ __forceinline__ void phase_na_attn(const Fr& F) {
    constexpr int KST = 72;
    bf16* KV = (bf16*)F.lds;
    float* rpbT = (float*)(F.lds + 36864 + 8 * 1536);
    const bf16* Qn = F.R(1); const bf16* Kn = F.R(2); const bf16* VT = F.R(3); const bf16* Z = F.R(4); bf16* Og = F.R(5);
    const int lane = F.lane, l15 = lane & 15, lq = lane >> 4, wave = F.wave, tid = F.tid;
    const int srow = tid >> 3, spart = (tid & 7) * 8;
    const int bxa = (int)blockIdx.x, bxcda = (gridDim.x == 256) ? (bxa & 7) * 32 + (bxa >> 3) : bxa;
    float kgc[8];
#pragma unroll
    for (int i = 0; i < 8; ++i) kgc[i] = F.a->in[23][spart + i];
    auto knorm = [&](u32x4 w) -> u32x4 {
        float x[8] = {lo_bf(w.x), hi_bf(w.x), lo_bf(w.y), hi_bf(w.y), lo_bf(w.z), hi_bf(w.z), lo_bf(w.w), hi_bf(w.w)};
        float ss = ((x[0] * x[0] + x[1] * x[1]) + (x[2] * x[2] + x[3] * x[3])) + ((x[4] * x[4] + x[5] * x[5]) + (x[6] * x[6] + x[7] * x[7]));
        ss += dppf<0xB1>(ss); ss += dppf<0x4E>(ss); ss += dppf<0x141>(ss);
        const float rstd = __builtin_amdgcn_rsqf(ss * (1.f / 64.f) + 1e-6f);
        u32x4 o; o.x = pk2(x[0] * rstd * kgc[0], x[1] * rstd * kgc[1]); o.y = pk2(x[2] * rstd * kgc[2], x[3] * rstd * kgc[3]); o.z = pk2(x[4] * rstd * kgc[4], x[5] * rstd * kgc[5]); o.w = pk2(x[6] * rstd * kgc[6], x[7] * rstd * kgc[7]);
        return o; };
    for (int bt = bxcda; bt < 2048 + 128; bt += gridDim.x) {
        int b, h, nrows, rlo = 0, gi = 0, q0 = 0, lo = 0, r0 = 0, qrow0;
        if (bt < 2048) { const int ip = bt & 31; h = (bt >> 5) & 15; b = bt >> 9; gi = 2 * ip + (wave >> 2); const int qt = wave & 3; q0 = 16 * qt; lo = qt == 0 ? 0 : (qt == 1 ? 8 : (qt == 2 ? 24 : 32));
            r0 = min(max(gi - 4, 0), 56); rlo = min(max(2 * ip - 4, 0), 56); nrows = min(max(2 * ip - 3, 0), 56) + 8 - rlo; qrow0 = b * TB + CTXL + gi * 64 + q0; }
        else { const int idx = bt - 2048; b = idx >> 5; h = (idx >> 1) & 15; nrows = 0; qrow0 = b * TB + 16 * (8 * (idx & 1) + wave); }
        const int ntl = nrows + 4;
        int boff[2][4];
#pragma unroll
        for (int st = 0; st < 2; ++st)
#pragma unroll
            for (int reg = 0; reg < 4; ++reg) { const int c = lo + 16 * st + 4 * lq + reg, qc = q0 + l15, cs = min(max(qc - 8, 0), 48); boff[st][reg] = (c >= cs && c < cs + 16) ? c - qc + 15 : -1; }
        __syncthreads();
        if (tid < 465) rpbT[tid] = F.a->in[24][h * 465 + tid];
        bf16x8 Qf[2];
        {
            u32x4 qw[2]; float qv[2][8]; float ss = 0.f;
#pragma unroll
            for (int ds = 0; ds < 2; ++ds) { qw[ds] = *(const u32x4*)(Qn + (size_t)(qrow0 + l15) * D + h * 64 + 32 * ds + 8 * lq);
#pragma unroll
                for (int i = 0; i < 4; ++i) { qv[ds][2 * i] = lo_bf(qw[ds][i]); qv[ds][2 * i + 1] = hi_bf(qw[ds][i]); ss += qv[ds][2 * i] * qv[ds][2 * i] + qv[ds][2 * i + 1] * qv[ds][2 * i + 1]; } }
            ss += __shfl_xor(ss, 16); ss += __shfl_xor(ss, 32);
            const float rstd = 0.125f / sqrtf(ss * (1.f / 64.f) + 1e-6f);
#pragma unroll
            for (int ds = 0; ds < 2; ++ds) { const float* qg = F.a->in[22] + 32 * ds + 8 * lq; u32x4 o;
#pragma unroll
                for (int i = 0; i < 4; ++i) o[i] = pk2(qv[ds][2 * i] * rstd * qg[2 * i], qv[ds][2 * i + 1] * rstd * qg[2 * i + 1]);
                Qf[ds] = __builtin_bit_cast(bf16x8, o); }
        }
        f32x4 O[4]; float lsum = 0.f;
#pragma unroll
        for (int dt = 0; dt < 4; ++dt) O[dt] = (f32x4){0.f, 0.f, 0.f, 0.f};
        const bf16* Kg = Kn + (size_t)b * TB * D + h * 64 + spart + (size_t)srow * D;
        const bf16* Vg = VT + ((size_t)(b * 16 + h) * 64 + srow) * TB + spart;
        u32x4 kr0, vr0, kr1, vr1;
#define NA_T0(TN) ((TN) < nrows ? CTXL + (rlo + (TN)) * 64 : 64 * ((TN) - nrows))
        { const int t0 = NA_T0(0); kr0 = *(const u32x4*)(Kg + (size_t)t0 * D); vr0 = *(const u32x4*)(Vg + t0); }
        { const int t1 = NA_T0(1); kr1 = *(const u32x4*)(Kg + (size_t)t1 * D); vr1 = *(const u32x4*)(Vg + t1); }
        *(u32x4*)(KV + srow * KST + spart) = knorm(kr0); *(u32x4*)(KV + 64 * KST + srow * KST + spart) = vr0;
        __syncthreads();
#define NA_STEP(KR_NEXT, VR_NEXT, KR_LOAD, VR_LOAD) do { \
            if (tix + 2 < ntl) { const int t2 = NA_T0(tix + 2); KR_LOAD = *(const u32x4*)(Kg + (size_t)t2 * D); VR_LOAD = *(const u32x4*)(Vg + t2); } \
            na_tile(); \
            if (tix + 1 < ntl) { bf16* Kw = KV + ((tix + 1) & 1) * (128 * KST); *(u32x4*)(Kw + srow * KST + spart) = knorm(KR_NEXT); *(u32x4*)(Kw + 64 * KST + srow * KST + spart) = VR_NEXT; } \
            __syncthreads(); } while (0)
        int tix = 0;
        auto na_tile = [&]() {
            const bf16* Kl = KV + (tix & 1) * (128 * KST); const bf16* Vl = Kl + 64 * KST;
            const bool nb = tix < nrows; const int rr = rlo + tix;
            const bool mine = nb ? (rr >= r0 && rr < r0 + 8) : true;
            if (mine) {
                const int nsub = nb ? 1 : 2;
                for (int sub = 0; sub < nsub; ++sub) {
                    const int koff = nb ? lo : 32 * sub;
                    f32x4 Sx[2];
#pragma unroll
                    for (int st = 0; st < 2; ++st) { Sx[st] = (f32x4){0.f, 0.f, 0.f, 0.f};
#pragma unroll
                        for (int ds = 0; ds < 2; ++ds) { const bf16x8 Kf = *(const bf16x8*)(Kl + (koff + 16 * st + l15) * KST + 32 * ds + 8 * lq);
                            Sx[st] = __builtin_amdgcn_mfma_f32_16x16x32_bf16(Kf, Qf[ds], Sx[st], 0, 0, 0); } }
                    float pv[2][4];
#pragma unroll
                    for (int st = 0; st < 2; ++st)
#pragma unroll
                        for (int reg = 0; reg < 4; ++reg) {
                            if (nb) { const int bo = boff[st][reg]; pv[st][reg] = bo >= 0 ? __expf(Sx[st][reg] + rpbT[(rr - gi + 7) * 31 + bo]) : 0.f; }
                            else pv[st][reg] = __expf(Sx[st][reg]); }
                    u32x4 pw; pw.x = f2bf(pv[0][0]) | (f2bf(pv[0][1]) << 16); pw.y = f2bf(pv[0][2]) | (f2bf(pv[0][3]) << 16); pw.z = f2bf(pv[1][0]) | (f2bf(pv[1][1]) << 16); pw.w = f2bf(pv[1][2]) | (f2bf(pv[1][3]) << 16);
                    lsum += ((lo_bf(pw.x) + hi_bf(pw.x)) + (lo_bf(pw.y) + hi_bf(pw.y))) + ((lo_bf(pw.z) + hi_bf(pw.z)) + (lo_bf(pw.w) + hi_bf(pw.w)));
                    const bf16x8 Pb = __builtin_bit_cast(bf16x8, pw);
#pragma unroll
                    for (int dt = 0; dt < 4; ++dt) { const bf16* vp = Vl + (16 * dt + l15) * KST + koff + 4 * lq;
                        u32x4 vw; const u32x2 v0 = *(const u32x2*)vp, v1 = *(const u32x2*)(vp + 16); vw.x = v0.x; vw.y = v0.y; vw.z = v1.x; vw.w = v1.y;
                        O[dt] = __builtin_amdgcn_mfma_f32_16x16x32_bf16(__builtin_bit_cast(bf16x8, vw), Pb, O[dt], 0, 0, 0); }
                }
            }
        };
        for (; tix + 1 < ntl; tix += 2) { NA_STEP(kr1, vr1, kr0, vr0); ++tix; NA_STEP(kr0, vr0, kr1, vr1); --tix; }
        if (tix < ntl) { NA_STEP(kr1, vr1, kr0, vr0); }
#undef NA_STEP
#undef NA_T0
        {
            float lt = lsum; lt += __shfl_xor(lt, 16); lt += __shfl_xor(lt, 32);
            const float inv = 1.f / lt; const size_t row = (size_t)(qrow0 + l15) * D + h * 64 + 4 * lq;
#pragma unroll
            for (int dt = 0; dt < 4; ++dt) { const u32x2 zw = *(const u32x2*)(Z + row + 16 * dt);
                u32x2 o; o.x = pk2(O[dt][0] * inv * silu(lo_bf(zw.x)), O[dt][1] * inv * silu(hi_bf(zw.x))); o.y = pk2(O[dt][2] * inv * silu(lo_bf(zw.y)), O[dt][3] * inv * silu(hi_bf(zw.y)));
                *(u32x2*)(Og + row + 16 * dt) = o; }
        }
    }
}

__device__ __forceinline__ void phase_s5_params(const Fr& F) {
    const int idx = blockIdx.x * NTHR + F.tid; if (idx >= 8192) return;
    const int p = idx & 63, g = (idx >> 6) & 63, s = idx >> 12;
    const float lr = F.a->in[27][idx], li = F.a->in[28][idx], step = expf(F.a->in[29][s * 64 + g]);
    const float mag = expf(lr * step), ar = mag * cosf(li * step), ai = mag * sinf(li * step), den = lr * lr + li * li;
    const float qr = ((ar - 1.f) * lr + ai * li) / den, qi = (ai * lr - (ar - 1.f) * li) / den;
    float pr = ar, pi = ai;
    for (int i = 0; i < 6; ++i) { const float nr = pr * pr - pi * pi, ni = 2.f * pr * pi; pr = nr; pi = ni; }
    float* A = (float*)(F.ws + OFF_S5A) + idx * 4; A[0] = ar; A[1] = ai; A[2] = pr; A[3] = pi;
    float* BB = (float*)(F.ws + OFF_BB) + (size_t)idx * 32;
    const float* br = F.a->in[30] + ((size_t)g * 64 + p) * 16; const float* bi = F.a->in[31] + ((size_t)g * 64 + p) * 16;
    for (int c = 0; c < 16; ++c) { BB[c] = qr * br[c] - qi * bi[c]; BB[16 + c] = qr * bi[c] + qi * br[c]; }
}
template <bool FINAL> __device__ __forceinline__ void phase_s5_scan(const Fr& F) {
    const bf16* U = F.R(1); float* E = (float*)F.R(6);
    float* BUl = (float*)(F.lds + F.wave * 16384);
    const int lane = F.lane, l15 = lane & 15, lq = lane >> 4;
    const float* BBf = (const float*)(F.ws + OFF_BB);
    const int sg = F.gw >> 4, g = sg & 63, s = sg >> 6;
    const f32x4 av = *(const f32x4*)((const float*)(F.ws + OFF_S5A) + (sg * 64 + lane) * 4);
    const float ar = av.x, ai = av.y;
    bf16x8 B1[8];
#pragma unroll
    for (int nt = 0; nt < 8; ++nt) {
        const int n = 16 * nt + l15; const float* bp = BBf + (size_t)(sg * 64 + (n & 63)) * 32 + 16 * (n >> 6) + 8 * (lq & 1);
        const f32x4 t0 = *(const f32x4*)bp, t1 = *(const f32x4*)(bp + 4); const float f[8] = {t0.x, t0.y, t0.z, t0.w, t1.x, t1.y, t1.z, t1.w};
        B1[nt] = lq < 2 ? pack8(f) : (bf16x8){0, 0, 0, 0, 0, 0, 0, 0};
    }
    bf16x8 Chi[4];
    if (FINAL) {
#pragma unroll
        for (int ks = 0; ks < 4; ++ks) {
            const int k = 32 * ks + 8 * lq; const float* cp = (k < 64 ? F.a->in[32] : F.a->in[33]) + (size_t)g * 1024 + l15 * 64 + (k & 63); const float sg_ = k < 64 ? 1.f : -1.f;
            const f32x4 t0 = *(const f32x4*)cp, t1 = *(const f32x4*)(cp + 4); const float f[8] = {sg_ * t0.x, sg_ * t0.y, sg_ * t0.z, sg_ * t0.w, sg_ * t1.x, sg_ * t1.y, sg_ * t1.z, sg_ * t1.w};
            Chi[ks] = pack8(f);
        }
    }
    u32x4 ua[4]; float e0 = 0.f, e1 = 0.f;
    {   const int ti = F.gw & 15, b = ti / 68, chunk = ti - b * 68;
#pragma unroll
        for (int sb = 0; sb < 4; ++sb) ua[sb] = lq < 2 ? *(const u32x4*)(U + ((size_t)b * TB + tokof(s, chunk * 64 + sb * 16 + l15)) * D + g * 16 + 8 * lq) : (u32x4){0u, 0u, 0u, 0u};
        if (FINAL) { const float* e = E + ((size_t)(((s * 4 + b) * 64 + g) * 68 + chunk) * 64 + lane) * 2; e0 = e[0]; e1 = e[1]; } }
    for (int ti = (F.gw & 15); ti < NB * 68; ti += 16) {
        const int b = ti / 68, chunk = ti - b * 68, sbg = (s * 4 + b) * 64 + g, task = sbg * 68 + chunk;
        float xr = FINAL ? e0 : 0.f, xi = FINAL ? e1 : 0.f;
        bf16* Yb = F.R(4 + s);
        u32x4 uc[4];
#pragma unroll
        for (int sb = 0; sb < 4; ++sb) uc[sb] = ua[sb];
        if (ti + 16 < NB * 68) {
            const int tn = ti + 16, bn = tn / 68, cn = tn - bn * 68;
#pragma unroll
            for (int sb = 0; sb < 4; ++sb) ua[sb] = lq < 2 ? *(const u32x4*)(U + ((size_t)bn * TB + tokof(s, cn * 64 + sb * 16 + l15)) * D + g * 16 + 8 * lq) : (u32x4){0u, 0u, 0u, 0u};
            if (FINAL) { const float* e = E + ((size_t)(((s * 4 + bn) * 64 + g) * 68 + cn) * 64 + lane) * 2; e0 = e[0]; e1 = e[1]; }
        }
#pragma unroll
        for (int sub = 0; sub < 4; ++sub) {
            const bf16x8 A1 = __builtin_bit_cast(bf16x8, uc[sub]);
#pragma unroll
            for (int nt = 0; nt < 8; ++nt) {
                f32x4 acc = {0.f, 0.f, 0.f, 0.f};
                acc = __builtin_amdgcn_mfma_f32_16x16x32_bf16(A1, B1[nt], acc, 0, 0, 0);
#pragma unroll
                for (int reg = 0; reg < 4; ++reg) BUl[(4 * lq + reg) * 132 + 16 * nt + l15] = acc[reg];
            }
            asm volatile("s_waitcnt lgkmcnt(0)" ::: "memory");
#pragma unroll 4
            for (int jj = 0; jj < 16; ++jj) {
                const float br_ = BUl[jj * 132 + lane], bi_ = BUl[jj * 132 + 64 + lane];
                const float nr = ar * xr - ai * xi + br_, ni = ar * xi + ai * xr + bi_; xr = nr; xi = ni;
                if (FINAL) { BUl[jj * 132 + lane] = xr; BUl[jj * 132 + 64 + lane] = xi; }
            }
            if (FINAL) {
                asm volatile("s_waitcnt lgkmcnt(0)" ::: "memory");
                f32x4 acc = {0.f, 0.f, 0.f, 0.f};
#pragma unroll
                for (int ks = 0; ks < 4; ++ks) {
                    const f32x4 t0 = *(const f32x4*)(BUl + l15 * 132 + 32 * ks + 8 * lq), t1 = *(const f32x4*)(BUl + l15 * 132 + 32 * ks + 8 * lq + 4);
                    const float xf[8] = {t0.x, t0.y, t0.z, t0.w, t1.x, t1.y, t1.z, t1.w};
                    acc = __builtin_amdgcn_mfma_f32_16x16x32_bf16(pack8(xf), Chi[ks], acc, 0, 0, 0);
                }
#pragma unroll
                for (int reg = 0; reg < 4; ++reg) { const int tok = tokof(s, chunk * 64 + sub * 16 + 4 * lq + reg);
                    Yb[((size_t)b * TB + tok) * D + g * 16 + l15] = (bf16)f2bf(acc[reg]); }
                asm volatile("s_waitcnt lgkmcnt(0)" ::: "memory");
            }
        }
        if (!FINAL) { float* e = E + ((size_t)task * 64 + lane) * 2; e[0] = xr; e[1] = xi; }
    }
}
__device__ __forceinline__ void phase_s5_carry(const Fr& F) {
    const int idx = blockIdx.x * NTHR + F.tid; if (idx >= 2 * NB * 64 * 64) return;
    const int p = idx & 63, sbg = idx >> 6, g = sbg & 63, s = sbg >> 8;
    const f32x4 av = *(const f32x4*)((const float*)(F.ws + OFF_S5A) + ((s * 64 + g) * 64 + p) * 4);
    float* E = (float*)F.R(6) + ((size_t)sbg * 68 * 64 + p) * 2;
    float er[68], ei[68];
#pragma unroll
    for (int c = 0; c < 68; ++c) { er[c] = E[(size_t)c * 128]; ei[c] = E[(size_t)c * 128 + 1]; }
    float cr = 0.f, ci = 0.f;
#pragma unroll
    for (int c = 0; c < 68; ++c) { E[(size_t)c * 128] = cr; E[(size_t)c * 128 + 1] = ci;
        const float nr = av.z * cr - av.w * ci + er[c], ni = av.z * ci + av.w * cr + ei[c]; cr = nr; ci = ni; }
}
__device__ __forceinline__ void phase_s5_combine(const Fr& F) {
    const bf16* U = F.R(1); const float* dsk = F.a->in[34];
    for (size_t i = (size_t)blockIdx.x * NTHR + F.tid; i < (size_t)NT * D / 4; i += (size_t)GRID * NTHR) {
        const size_t e = i * 4; const int c = (int)(e & 1023);
        const u32x2 y0 = *(const u32x2*)(F.R(4) + e), y1 = *(const u32x2*)(F.R(5) + e), uw = *(const u32x2*)(U + e); const f32x4 d = *(const f32x4*)(dsk + c);
        float y[4] = {lo_bf(y0.x) + lo_bf(y1.x) + d.x * lo_bf(uw.x), hi_bf(y0.x) + hi_bf(y1.x) + d.y * hi_bf(uw.x), lo_bf(y0.y) + lo_bf(y1.y) + d.z * lo_bf(uw.y), hi_bf(y0.y) + hi_bf(y1.y) + d.w * hi_bf(uw.y)};
#pragma unroll
        for (int k = 0; k < 4; ++k) { const float x = y[k]; y[k] = 0.5f * x * (1.f + tanh_fast(0.7978845608f * (x + 0.044715f * x * x * x))); }
        u32x2 o; o.x = pk2(y[0], y[1]); o.y = pk2(y[2], y[3]); *(u32x2*)(F.R(0) + e) = o;
    }
}

#define LAS __attribute__((address_space(3)))
#define XB_TMO      128
#define XB_XCNT(j)  (256  + 64 * (j))
#define XB_XSUB(j)  (1280 + 64 * (j))
#define XB_XGEN(j)  (2304 + 64 * (j))
#define XB_TOP      3328
#define XB_TOPGEN   3392
#define XCD_BAR_WORDS 3456
#define XB_SPIN_CAP (1u << 18)

__device__ __forceinline__ unsigned xb_ld(unsigned* p)              { return __hip_atomic_load(p, __ATOMIC_RELAXED, __HIP_MEMORY_SCOPE_AGENT); }
__device__ __forceinline__ unsigned xb_add(unsigned* p, unsigned v) { return __hip_atomic_fetch_add(p, v, __ATOMIC_RELAXED, __HIP_MEMORY_SCOPE_AGENT); }
__device__ __forceinline__ unsigned xb_xcc_id() { return (unsigned)__builtin_amdgcn_s_getreg((3 << 11) | 20) & 0xFu; }
#define XB_SPIN(cond, bar) do { unsigned _sp = 0; while (cond) { __builtin_amdgcn_s_sleep(1); \
    if ((++_sp & 255u) == 0u) { if (xb_ld(&(bar)[XB_TMO])) break; if (_sp > XB_SPIN_CAP) { atomicAdd(&(bar)[XB_TMO], 1u); break; } } } } while (0)

struct XcdBarrier {
    unsigned* bar; unsigned x;
    volatile LAS unsigned* st;
};

__device__ __forceinline__ XcdBarrier xcd_barrier_post(unsigned* bar, volatile LAS unsigned* st) {
    XcdBarrier b; b.bar = bar; b.x = xb_xcc_id(); b.st = st;
    if (threadIdx.x == 0) (void)xb_add(&bar[XB_XCNT(b.x)], 1u);
    return b;
}
__device__ __forceinline__ void xcd_barrier_complete(unsigned* bar, unsigned x, unsigned& nloc, unsigned& nx) {
    const unsigned G = gridDim.x * gridDim.y * gridDim.z;
    unsigned sum, cnt, mine, sp = 0u;
    for (;;) {
        sum = 0u; cnt = 0u; mine = 0u;
#pragma unroll
        for (unsigned j = 0; j < 16; ++j) { const unsigned c = xb_ld(&bar[XB_XCNT(j)]); sum += c; cnt += (c > 0u) ? 1u : 0u; mine = (j == x) ? c : mine; }
        if (sum == G) break;
        __builtin_amdgcn_s_sleep(1);
        if ((++sp & 255u) == 0u) { if (xb_ld(&bar[XB_TMO])) break; if (sp > XB_SPIN_CAP) { atomicAdd(&bar[XB_TMO], 1u); break; } }
    }
    nloc = mine > 0u ? mine : 1u; nx = cnt > 0u ? cnt : 1u;
}

__device__ __forceinline__ void xcd_barrier(const XcdBarrier& b) {
    asm volatile("s_waitcnt vmcnt(0)" ::: "memory");
    __syncthreads();
    if (threadIdx.x == 0) {
        unsigned* bar = b.bar;
        __builtin_amdgcn_s_waitcnt(0);
        unsigned nloc = b.st[0], nx = b.st[1];
        if (nloc == 0u) { xcd_barrier_complete(bar, b.x, nloc, nx); b.st[0] = nloc; b.st[1] = nx; }
        const unsigned old = xb_add(&bar[XB_XSUB(b.x)], 1u);
        const unsigned gen = old / nloc;
        if (old + 1u == (gen + 1u) * nloc) {
            __builtin_amdgcn_fence(__ATOMIC_RELEASE, "agent");
            asm volatile("s_waitcnt vmcnt(0)" ::: "memory");
            const unsigned og = xb_add(&bar[XB_TOP], 1u);
            const unsigned tg = og / nx;
            if (og + 1u == (tg + 1u) * nx) xb_add(&bar[XB_TOPGEN], 1u);
            else XB_SPIN(xb_ld(&bar[XB_TOPGEN]) == tg, bar);
            __builtin_amdgcn_fence(__ATOMIC_ACQUIRE, "agent");
            xb_add(&bar[XB_XGEN(b.x)], 1u);
            asm volatile("s_waitcnt vmcnt(0)" ::: "memory");
        } else {
            XB_SPIN(xb_ld(&bar[XB_XGEN(b.x)]) == gen, bar);
            __builtin_amdgcn_fence(__ATOMIC_ACQUIRE, "agent");
            asm volatile("s_waitcnt vmcnt(0)" ::: "memory");
        }
    }
    __syncthreads();
}

constexpr int NPHASE = 28;
#ifndef PROBE_MASK
#define PROBE_MASK 0
#endif
__device__ __forceinline__ void phase_na_qknorm_dummy(const Fr& F) {}

#define PH(k) if (args.ph_lo <= (k) && (k) < args.ph_hi)
#define SEAM(k) if (args.ph_lo <= (k) && (k) + 1 < args.ph_hi) { if ((k) == 0) grid.sync(); else { xcd_barrier(bar); if (PROBE_MASK & 32) { xcd_barrier(bar); xcd_barrier(bar); } } }
#define RWKV_LAYER(P0, L, JR, XO, CO, OUTN, OUTMODE) \
    PH(P0 + 0) { if (L == 3) conv_rwkv(F, 1); phase_norm_mix(F, L, JR, 4, 0, 1, 4, 5); } SEAM(P0 + 0); \
    if (PROBE_MASK & 8) { phase_norm_mix(F, L, JR, 4, 0, 1, 4, 5); xcd_barrier(bar); } \
    PH(P0 + 1) { run_gemm(F, F.R(0), F.WT(), D, 680, 1, 0, FRkv{F.R(4), F.R(5), F.R(6)}); } SEAM(P0 + 1); \
    if (PROBE_MASK & 16) { run_gemm(F, F.R(0), F.WT(), D, 680, 1, 0, FRkv{F.R(4), F.R(5), F.R(6)}); xcd_barrier(bar); } \
    PH(P0 + 2) { phase_norm_mix(F, L, JR, 2, 2, 3, 0, 0); } SEAM(P0 + 2); \
    PH(P0 + 3) { run_gemm(F, F.R(0), F.WT() + (size_t)2560 * D, D, 544, 2, 0, FRkv{F.R(2), F.R(3), nullptr}); } SEAM(P0 + 3); \
    PH(P0 + 4) { phase_rwkv_scan(F, JR); } SEAM(P0 + 4); \
    if (PROBE_MASK & 1) { phase_rwkv_scan(F, JR); xcd_barrier(bar); } \
    PH(P0 + 5) { phase_rwkv_post(F, JR); } SEAM(P0 + 5); \
    PH(P0 + 6) { run_gemm(F, F.R(0), F.WT() + (size_t)4608 * D, D, OUTN, OUTMODE, 4, FResid{XO, CO, args.out, F.ctxbuf(), F.mod(L)}); } SEAM(P0 + 6);
__global__ void __launch_bounds__(NTHR) fwd_kernel(Args args) {
    extern __shared__ __attribute__((aligned(16))) unsigned char lds[];
    cg::grid_group grid = cg::this_grid();
    Fr F; F.a = &args; F.lds = lds; F.ws = args.ws; F.tid = threadIdx.x; F.lane = F.tid & 63; F.wave = __builtin_amdgcn_readfirstlane(F.tid >> 6); F.gw = blockIdx.x * NWAVES + F.wave;
    volatile LAS unsigned* bst = (volatile LAS unsigned*)((LAS unsigned char*)lds + 131072 + 1024);
    if (F.tid < 2) bst[F.tid] = 0u;
    __syncthreads();
    XcdBarrier bar = xcd_barrier_post((unsigned*)(args.ws + OFF_BAR), bst);
    PH(0) { phase_mod(F); conv_rwkv(F, 0); phase_s5_params(F); } SEAM(0);
    RWKV_LAYER(1, 0, 0, args.in[0], args.in[2], 272, 0)
    PH(8) { conv_mat(F, args.in[21], D, 4 * D, F.WT(), 0); conv_mat(F, args.in[25], D, D, F.WT(), 4096); phase_norm_plain(F, 1); } SEAM(8);
    PH(9) { run_gemm(F, F.R(0), F.WT(), D, 1088, 0, 16, FNaIn{F.R(1), F.R(2), F.R(3), F.R(4)}); } SEAM(9);
    PH(11) { phase_na_attn(F); } SEAM(11);
    if (PROBE_MASK & 4) { phase_na_attn(F); xcd_barrier(bar); }
    PH(12) { run_gemm(F, F.R(5), F.WT() + (size_t)4096 * D, D, 272, 0, 4, FResid{args.out, F.ctxbuf(), args.out, F.ctxbuf(), F.mod(1)}); } SEAM(12);
    PH(13) { conv_mat(F, args.in[26], D, 2 * D, F.WT(), 0); conv_mat(F, args.in[35], D, D, F.WT(), 2048); conv_mat(F, args.in[37], D, D, F.WT(), 3072); phase_norm_plain(F, 2); } SEAM(13);
    PH(14) { run_gemm(F, F.R(0), F.WT(), D, 544, 0, 8, FS5In{F.R(1), F.R(3)}); } SEAM(14);
    PH(15) { phase_s5_scan<false>(F); } SEAM(15);
    PH(16) { phase_s5_carry(F); } SEAM(16);
    PH(17) { phase_s5_scan<true>(F); } SEAM(17);
    if (PROBE_MASK & 2) { phase_s5_scan<false>(F); grid.sync(); phase_s5_carry(F); grid.sync(); phase_s5_scan<true>(F); xcd_barrier(bar); }
    PH(18) { phase_s5_combine(F); } SEAM(18);
    PH(19) { run_gemm(F, F.R(0), F.WT() + (size_t)2048 * D, D, 272, 0, 4, FGlu{F.R(0), F.R(3), args.in[36], F.R(4)}); } SEAM(19);
    PH(20) { run_gemm(F, F.R(4), F.WT() + (size_t)3072 * D, D, 272, 0, 4, FResid{args.out, F.ctxbuf(), args.out, F.ctxbuf(), F.mod(2)}); } SEAM(20);
    RWKV_LAYER(21, 3, 1, args.out, F.ctxbuf(), 256, 3)
}

#ifndef MULTI_LAUNCH
#define MULTI_LAUNCH 0
#endif
extern "C" void kernel_launch(void* const* d_in, const int* in_sizes, int n_in, void* d_out, int out_size, void* d_ws, size_t ws_size, hipStream_t stream) {
    static int ready = 0;
    if (ready == 0) {
        ready = -1;
        if (n_in != 38 || ws_size < WS_NEED || out_size != NB * SEQ * D) { fprintf(stderr, "kernel_launch: unexpected problem (n_in %d ws %zu out %d)\n", n_in, ws_size, out_size); return; }
        if (hipFuncSetAttribute((const void*)fwd_kernel, hipFuncAttributeMaxDynamicSharedMemorySize, LDS_BYTES) != hipSuccess) { fprintf(stderr, "kernel_launch: hipFuncSetAttribute failed\n"); return; }
        int dev = 0, cus = 0, per_cu = 0;
        hipGetDevice(&dev); hipDeviceGetAttribute(&cus, hipDeviceAttributeMultiprocessorCount, dev);
        hipOccupancyMaxActiveBlocksPerMultiprocessor(&per_cu, (const void*)fwd_kernel, NTHR, LDS_BYTES);
        if (cus * per_cu < GRID) { fprintf(stderr, "kernel_launch: grid of %d not resident (%d CUs x %d)\n", GRID, cus, per_cu); return; }
        ready = 1;
    }
    if (ready < 0) return;
    if (hipMemsetAsync((char*)d_ws + OFF_BAR, 0, XCD_BAR_WORDS * 4, stream) != hipSuccess) { fprintf(stderr, "kernel_launch: memset failed\n"); return; }
    Args a{};
    for (int i = 0; i < 38; ++i) a.in[i] = (const float*)d_in[i];
    a.out = (float*)d_out; a.ws = (unsigned char*)d_ws;
#if MULTI_LAUNCH
    for (int ph = 0; ph < NPHASE; ++ph) { a.ph_lo = ph; a.ph_hi = ph + 1; hipLaunchKernelGGL(fwd_kernel, dim3(GRID), dim3(NTHR), LDS_BYTES, stream, a); }
#else
    a.ph_lo = 0; a.ph_hi = NPHASE;
    void* kargs[] = {&a};
    hipError_t e = hipLaunchCooperativeKernel((const void*)fwd_kernel, dim3(GRID), dim3(NTHR), kargs, LDS_BYTES, stream);
    if (e != hipSuccess) fprintf(stderr, "cooperative launch failed: %s\n", hipGetErrorString(e));
#endif
}
```

```cpp
#include <hip/hip_runtime.h>
#include <hip/hip_cooperative_groups.h>
#include <cstdio>
#include <cstdint>
namespace cg = cooperative_groups;

namespace pg8 {
#define PG8_LAS __attribute__((address_space(3)))
typedef unsigned short bf16_t;
typedef short bf16x8 __attribute__((ext_vector_type(8)));
typedef float f32x4 __attribute__((ext_vector_type(4)));
typedef unsigned u32x4 __attribute__((ext_vector_type(4)));
constexpr int BM = 256, BK = 64, HALF = 128, HTB = HALF * BK * 2  , STAGE_BYTES = 8 * HTB, NXCD = 8, WGM = 8;

__host__ __device__ __forceinline__ int lds_byte(int r, int c) { const int st = (r >> 4) * 2 + (c >> 5), rr = r & 15, cc = c & 31, ob = rr * 64 + cc * 2; return st * 1024 + (ob ^ (((ob >> 9) & 1) << 5)); }
__host__ __device__ __forceinline__ void stage_rc(int b, int& R, int& C) { const int st = b / 1024, sb = b % 1024, swz = sb ^ (((sb >> 9) & 1) << 5); R = (st >> 1) * 16 + swz / 64; C = (st & 1) * 32 + (swz % 64) / 2; }
__host__ __device__ __forceinline__ int perm32(int rho) { const int n = rho >> 4, i = rho & 15; return 8 * (i >> 2) + 4 * n + (i & 3); }

struct Unit { int pm, pn; };
struct Gemm { const bf16_t* A; const bf16_t* Bt; int M, N, K; };

struct ListOrder {
    int n, G, c, mode, nN;
    __device__ __forceinline__ bool next(int i, Unit& u) const {
        const int L = i * G + c; if (L >= n) return false;
        if (mode == 0) { u.pm = L / nN; u.pn = L - u.pm * nN; }
        else if (mode == 1) {
            if (L < 544) { const int nn = L / 272, rem = L - nn * 272; u.pm = nn * 68 + (rem >> 2); u.pn = nn * 4 + (rem & 3); }
            else { const int Lp = L - 544, nn = 2 + Lp / 68; u.pm = nn * 68 + Lp % 68; u.pn = 8 + (nn - 2); }
        } else if (mode == 4) { const int nn = L / 272, rem = L - nn * 272; u.pm = rem >> 2; u.pn = nn * 4 + (rem & 3); }
        else if (mode == 3) { const int q = L >> 2; u.pm = (q >> 4) * 17 + (q & 15) + 1; u.pn = L & 3; }
        else { const int nn = L / 272, rem = L - nn * 272; u.pm = nn * 68 + (rem >> 2); u.pn = nn * 4 + (rem & 3); }
        return true;
    }
    __device__ __forceinline__ void a_ready(const Unit&) const {}
    __device__ __forceinline__ void done(const Unit&) const {}
};
template <class F> struct EpiT {
    static constexpr bool PERM = true, AFTER_DRAIN = false;
    F f;
    __device__ __forceinline__ void operator()(const f32x4 (&acc)[2][2][4][2], const Unit& u, int wr, int wc, int fr, int fq) const {
#pragma unroll
        for (int ai = 0; ai < 2; ++ai)
#pragma unroll
            for (int m = 0; m < 4; ++m)
#pragma unroll
                for (int bj = 0; bj < 2; ++bj) f(u, ai * 128 + wr * 64 + m * 16 + fr, bj * 128 + wc * 32 + 8 * fq, acc[ai][bj][m][0], acc[ai][bj][m][1]);
    }
};
template <class Epi, class Sched, bool ALIGN_EPI = false, bool SP2 = false>
__device__ __forceinline__ void gemm_phase(PG8_LAS unsigned char* lds, const Gemm g, const Sched& S, const Epi& E) {
    const int tid = threadIdx.x, wid = __builtin_amdgcn_readfirstlane(tid >> 6), lane = tid & 63, wr = wid >> 2, wc = wid & 3, fr = lane & 15, fq = lane >> 4;
    const int K = g.K, nt = K / BK;
    unsigned voffA[2], voffB[2];
#pragma unroll
    for (int i = 0; i < 2; ++i) { int R, C; stage_rc(tid * 16 + i * 8192, R, C); const int Rb = Epi::PERM ? ((R & ~31) + perm32(R & 31)) : R;
        voffA[i] = (unsigned)(R * K + C) * 2u; voffB[i] = (unsigned)(Rb * K + C) * 2u; }
    const size_t kstep = (size_t)(BK * 2);
    const size_t hstep = (size_t)HALF * K * 2;
    const size_t tstep = 2 * hstep;
    const unsigned ldsw = (unsigned)wid * 1024u;
    const int aoff = lds_byte(wr * 64 + fr, fq * 8), boff = lds_byte(wc * 32 + fr, fq * 8);
#define PG8_SA(b, h) (((b) * 2 + (h)) * HTB)
#define PG8_SB(b, h) ((4 + (b) * 2 + (h)) * HTB)
#define PG8_STAGE(bufoff, gbase, voff) do { _Pragma("unroll") for (int _i = 0; _i < 2; ++_i) \
        __builtin_amdgcn_global_load_lds((const unsigned*)((const char*)(gbase) + (voff)[_i]), (PG8_LAS unsigned*)(lds + (bufoff) + ldsw + _i * 8192), 16, 0, 0); } while (0)
#define PG8_LDA(dst, b, h) do { _Pragma("unroll") for (int m = 0; m < 4; ++m) _Pragma("unroll") for (int k = 0; k < 2; ++k) dst[m][k] = *(const PG8_LAS bf16x8*)(lds + PG8_SA(b, h) + aoff + m * 2048 + k * 1024); } while (0)
#define PG8_LDB(dst, b, h) do { _Pragma("unroll") for (int n = 0; n < 2; ++n) _Pragma("unroll") for (int k = 0; k < 2; ++k) dst[n][k] = *(const PG8_LAS bf16x8*)(lds + PG8_SB(b, h) + boff + n * 2048 + k * 1024); } while (0)
#define PG8_MMA(ai, bj, At, Bt) do { __builtin_amdgcn_s_setprio(1); _Pragma("unroll") for (int m = 0; m < 4; ++m) _Pragma("unroll") for (int n = 0; n < 2; ++n) _Pragma("unroll") for (int k = 0; k < 2; ++k) \
        acc[ai][bj][m][n] = __builtin_amdgcn_mfma_f32_16x16x32_bf16(Bt[n][k], At[m][k], acc[ai][bj][m][n], 0, 0, 0); __builtin_amdgcn_s_setprio(0); } while (0)
#define PG8_WAIT_V(n) asm volatile("s_waitcnt vmcnt(" #n ")" ::: "memory")
#define PG8_WAIT_L(n) asm volatile("s_waitcnt lgkmcnt(" #n ")" ::: "memory")
#define PG8_BAR __builtin_amdgcn_s_barrier()
#define PG8_SCHED __builtin_amdgcn_sched_barrier(0)
    Unit cur, nxt; int ui = 0;
    if (!S.next(0, cur)) return;
    f32x4 acc[2][2][4][2];
#pragma unroll
    for (int a = 0; a < 2; ++a)
#pragma unroll
        for (int b = 0; b < 2; ++b)
#pragma unroll
            for (int m = 0; m < 4; ++m)
#pragma unroll
                for (int n = 0; n < 2; ++n) acc[a][b][m][n] = (f32x4){0.f, 0.f, 0.f, 0.f};
    bf16x8 At[4][2], B0[2][2], B1[2][2];
    const char* cA = (const char*)g.A + (size_t)cur.pm * tstep; const char* cB = (const char*)g.Bt + (size_t)cur.pn * tstep;
    S.a_ready(cur);
    if constexpr (SP2) {
        PG8_STAGE(PG8_SB(0, 0), cB, voffB); PG8_STAGE(PG8_SB(0, 1), cB + hstep, voffB); PG8_STAGE(PG8_SA(0, 0), cA, voffA); PG8_STAGE(PG8_SA(0, 1), cA + hstep, voffA);
        if (wr == 1) PG8_BAR;
        PG8_WAIT_V(2); PG8_BAR;
        PG8_STAGE(PG8_SB(1, 0), cB + kstep, voffB); PG8_STAGE(PG8_SA(1, 0), cA + kstep, voffA); PG8_STAGE(PG8_SB(1, 1), cB + hstep + kstep, voffB);
        PG8_WAIT_V(6); PG8_BAR;
    } else {
        PG8_STAGE(PG8_SB(0, 0), cB, voffB); PG8_STAGE(PG8_SA(0, 0), cA, voffA); PG8_STAGE(PG8_SB(0, 1), cB + hstep, voffB); PG8_STAGE(PG8_SA(0, 1), cA + hstep, voffA);
        if (wr == 1) PG8_BAR;
        PG8_WAIT_V(4); PG8_BAR;
        PG8_STAGE(PG8_SB(1, 0), cB + kstep, voffB); PG8_STAGE(PG8_SA(1, 0), cA + kstep, voffA); PG8_STAGE(PG8_SB(1, 1), cB + hstep + kstep, voffB);
        PG8_WAIT_V(6); PG8_BAR;
    }
    for (;;) {
        const bool has_next = S.next(ui + 1, nxt);
        const char* nA = has_next ? (const char*)g.A + (size_t)nxt.pm * tstep : cA; const char* nB = has_next ? (const char*)g.Bt + (size_t)nxt.pn * tstep : cB;
        for (int t = 0; t < nt; t += 2) {
            const bool last = (t == nt - 2);
            const char* a1 = cA + (size_t)(t + 1) * kstep;
            const char* a2 = last ? nA : cA + (size_t)(t + 2) * kstep; const char* b2 = last ? nB : cB + (size_t)(t + 2) * kstep;
            const char* a3 = a2 + kstep; const char* b3 = b2 + kstep;
            if (last && has_next) S.a_ready(nxt);
            if constexpr (SP2) {
            PG8_LDB(B0, 0, 0); PG8_LDB(B1, 0, 1); PG8_SCHED; PG8_LDA(At, 0, 0); PG8_STAGE(PG8_SA(1, 1), a1 + hstep, voffA);
            PG8_WAIT_V(8); PG8_WAIT_L(0); PG8_BAR; PG8_MMA(0, 0, At, B0); PG8_MMA(0, 1, At, B1); PG8_BAR; PG8_SCHED;
            PG8_LDA(At, 0, 1); PG8_STAGE(PG8_SB(0, 0), b2, voffB); PG8_STAGE(PG8_SB(0, 1), b2 + hstep, voffB); PG8_STAGE(PG8_SA(0, 0), a2, voffA);
            PG8_WAIT_V(8); PG8_WAIT_L(0); PG8_BAR; PG8_MMA(1, 0, At, B0); PG8_MMA(1, 1, At, B1); PG8_BAR; PG8_SCHED;
            PG8_LDB(B0, 1, 0); PG8_LDB(B1, 1, 1); PG8_SCHED; PG8_LDA(At, 1, 0); PG8_STAGE(PG8_SA(0, 1), a2 + hstep, voffA);
            PG8_WAIT_V(8); PG8_WAIT_L(0); PG8_BAR; PG8_MMA(0, 0, At, B0); PG8_MMA(0, 1, At, B1); PG8_BAR; PG8_SCHED;
            PG8_LDA(At, 1, 1); PG8_STAGE(PG8_SB(1, 0), b3, voffB); PG8_STAGE(PG8_SB(1, 1), b3 + hstep, voffB); PG8_STAGE(PG8_SA(1, 0), a3, voffA);
            PG8_WAIT_V(8); PG8_WAIT_L(0); PG8_BAR; PG8_MMA(1, 0, At, B0); PG8_MMA(1, 1, At, B1); PG8_BAR; PG8_SCHED;
            } else {
            PG8_LDB(B0, 0, 0); PG8_SCHED; PG8_LDA(At, 0, 0); PG8_STAGE(PG8_SA(1, 1), a1 + hstep, voffA);
            PG8_WAIT_L(8); PG8_BAR; PG8_WAIT_L(0); PG8_MMA(0, 0, At, B0); PG8_BAR; PG8_SCHED;
            PG8_LDB(B1, 0, 1); PG8_STAGE(PG8_SB(0, 0), b2, voffB);
            PG8_BAR; PG8_WAIT_L(0); PG8_MMA(0, 1, At, B1); PG8_BAR;
            PG8_LDA(At, 0, 1); PG8_STAGE(PG8_SA(0, 0), a2, voffA);
            PG8_BAR; PG8_WAIT_L(0); PG8_MMA(1, 0, At, B0); PG8_BAR; PG8_SCHED;
            PG8_STAGE(PG8_SB(0, 1), b2 + hstep, voffB);
            PG8_WAIT_V(6); PG8_BAR; PG8_MMA(1, 1, At, B1); PG8_BAR;
            PG8_LDB(B0, 1, 0); PG8_SCHED; PG8_LDA(At, 1, 0); PG8_STAGE(PG8_SA(0, 1), a2 + hstep, voffA);
            PG8_WAIT_L(8); PG8_BAR; PG8_WAIT_L(0); PG8_MMA(0, 0, At, B0); PG8_BAR; PG8_SCHED;
            PG8_LDB(B1, 1, 1); PG8_STAGE(PG8_SB(1, 0), b3, voffB);
            PG8_BAR; PG8_WAIT_L(0); PG8_MMA(0, 1, At, B1); PG8_BAR;
            PG8_LDA(At, 1, 1); PG8_STAGE(PG8_SA(1, 0), a3, voffA);
            PG8_BAR; PG8_WAIT_L(0); PG8_MMA(1, 0, At, B0); PG8_BAR; PG8_SCHED;
            PG8_STAGE(PG8_SB(1, 1), b3 + hstep, voffB);
            PG8_WAIT_V(6); PG8_BAR; PG8_MMA(1, 1, At, B1); PG8_BAR;
            }
        }
        if constexpr (ALIGN_EPI) { if (wr == 0) PG8_BAR; }
        if constexpr (!Epi::AFTER_DRAIN) { E(acc, cur, wr, wc, fr, fq); S.done(cur); }
        if (!has_next) break;
#pragma unroll
        for (int a = 0; a < 2; ++a)
#pragma unroll
            for (int b = 0; b < 2; ++b)
#pragma unroll
                for (int m = 0; m < 4; ++m)
#pragma unroll
                    for (int n = 0; n < 2; ++n) acc[a][b][m][n] = (f32x4){0.f, 0.f, 0.f, 0.f};
        cur = nxt; cA = nA; cB = nB; ++ui;
        if constexpr (ALIGN_EPI) { if (wr == 1) PG8_BAR; }
    }
    PG8_WAIT_V(0);
    if constexpr (!ALIGN_EPI) { if (wr == 0) PG8_BAR; }
    PG8_BAR;
    if constexpr (Epi::AFTER_DRAIN) { E.fused(acc, cur, wr, wc, fr, fq, lds, wid, lane); S.done(cur); }
#undef PG8_SA
#undef PG8_SB
#undef PG8_STAGE
#undef PG8_LDA
#undef PG8_LDB
#undef PG8_MMA
#undef PG8_WAIT_V
#undef PG8_WAIT_L
#undef PG8_BAR
#undef PG8_SCHED
}
}

constexpr int NB = 4, SEQ = 4096, CTXL = 256, TB = SEQ + CTXL  , NT = NB * TB  , D = 1024, NMT = NT / 256  ;
constexpr int NWAVES = 8, NTHR = 512, GRID = 256;
constexpr size_t MiB = 1u << 20;
constexpr size_t OFF_MOD = 0, OFF_S5A = 256 * 1024, OFF_BAR = 512 * 1024, OFF_BB = 1 * MiB, OFF_L2T = 2 * MiB, OFF_CTX = 3 * MiB, OFF_WT = 7 * MiB, OFF_R0 = 18 * MiB, RSZ = 34 * MiB;
constexpr size_t WS_NEED = OFF_R0 + 7 * RSZ;
constexpr int LDS_BYTES = 147456;

typedef unsigned short bf16;
typedef float f32x4 __attribute__((ext_vector_type(4)));
typedef short bf16x8 __attribute__((ext_vector_type(8)));
typedef unsigned u32x4 __attribute__((ext_vector_type(4)));
typedef unsigned u32x2 __attribute__((ext_vector_type(2)));

__device__ __forceinline__ float bf2f(unsigned v) { return __builtin_bit_cast(float, v << 16); }
__device__ __forceinline__ unsigned f2bf(float f) { unsigned u = __builtin_bit_cast(unsigned, f); return (u + 0x7fffu + ((u >> 16) & 1u)) >> 16; }
__device__ __forceinline__ unsigned f2bf_hw(float f) { unsigned r; asm("v_cvt_pk_bf16_f32 %0, %1, %1" : "=v"(r) : "v"(f)); return r & 0xffffu; }
__device__ __forceinline__ unsigned pk2(float lo, float hi) { unsigned r; asm("v_cvt_pk_bf16_f32 %0, %1, %2" : "=v"(r) : "v"(lo), "v"(hi)); return r; }
__device__ __forceinline__ float lo_bf(unsigned w) { return __builtin_bit_cast(float, w << 16); }
__device__ __forceinline__ float hi_bf(unsigned w) { return __builtin_bit_cast(float, w & 0xffff0000u); }
__device__ __forceinline__ void store8(bf16* p, f32x4 a, f32x4 b) { u32x4 w; w.x = pk2(a.x, a.y); w.y = pk2(a.z, a.w); w.z = pk2(b.x, b.y); w.w = pk2(b.z, b.w); *(u32x4*)p = w; }
__device__ __forceinline__ float sigm(float x) { return __builtin_amdgcn_rcpf(1.f + __expf(-x)); }
__device__ __forceinline__ float tanh_fast(float x) { return 1.f - 2.f * __builtin_amdgcn_rcpf(1.f + __expf(2.f * x)); }
__device__ __forceinline__ float silu(float x) { return x * __builtin_amdgcn_rcpf(1.f + __expf(-x)); }
__device__ __forceinline__ unsigned cvt_pk_bf16(float lo, float hi) { unsigned r; asm("v_cvt_pk_bf16_f32 %0, %1, %2" : "=v"(r) : "v"(lo), "v"(hi)); return r; }
__device__ __forceinline__ bf16x8 pack8(const float (&f)[8]) { u32x4 h; h.x = pk2(f[0], f[1]); h.y = pk2(f[2], f[3]); h.z = pk2(f[4], f[5]); h.w = pk2(f[6], f[7]); return __builtin_bit_cast(bf16x8, h); }
__device__ __forceinline__ void split8(const float (&f)[8], bf16x8& hi, bf16x8& lo) {
    u32x4 h, l;
#pragma unroll
    for (int i = 0; i < 4; ++i) { const unsigned hw = cvt_pk_bf16(f[2 * i], f[2 * i + 1]); h[i] = hw; l[i] = cvt_pk_bf16(f[2 * i] - lo_bf(hw), f[2 * i + 1] - hi_bf(hw)); }
    hi = __builtin_bit_cast(bf16x8, h); lo = __builtin_bit_cast(bf16x8, l);
}
template <int CTRL> __device__ __forceinline__ float dppf(float x) { return __builtin_bit_cast(float, __builtin_amdgcn_update_dpp(0, __builtin_bit_cast(int, x), CTRL, 0xF, 0xF, false)); }
__device__ __forceinline__ float allred16(float x) { x += dppf<0x128>(x); x += dppf<0x124>(x); x += dppf<0x122>(x); x += dppf<0x121>(x); return x; }
__device__ __forceinline__ float wave_sum(float v) {
    v = allred16(v);
    const float s0 = __builtin_bit_cast(float, __builtin_amdgcn_readlane(__builtin_bit_cast(int, v), 0)), s1 = __builtin_bit_cast(float, __builtin_amdgcn_readlane(__builtin_bit_cast(int, v), 16));
    const float s2 = __builtin_bit_cast(float, __builtin_amdgcn_readlane(__builtin_bit_cast(int, v), 32)), s3 = __builtin_bit_cast(float, __builtin_amdgcn_readlane(__builtin_bit_cast(int, v), 48));
    return (s0 + s1) + (s2 + s3);
}
__device__ __forceinline__ int tokof(int s, int q) { return s == 0 ? q : (q < CTXL ? (CTXL - 1 - q) : (TB + CTXL - 1 - q)); }

struct Args { const float* in[38]; float* out; unsigned char* ws; int ph_lo, ph_hi; };

struct Fr {
    const Args* a; unsigned char* lds; unsigned char* ws; int tid, lane, wave, gw;
    __device__ __forceinline__ bf16* R(int i) const { return (bf16*)(ws + OFF_R0 + (size_t)i * RSZ); }
    __device__ __forceinline__ float* mod(int l) const { return (float*)(ws + OFF_MOD) + l * 5 * 3072; }
    __device__ __forceinline__ bf16* WT() const { return (bf16*)(ws + OFF_WT); }
    __device__ __forceinline__ bf16* WTb(int l) const { return (l & 1) ? (bf16*)(ws + OFF_R0 + 6 * RSZ + 20 * MiB) : (bf16*)(ws + OFF_WT); }
    __device__ __forceinline__ float* ctxbuf() const { return (float*)(ws + OFF_CTX); }
};
__device__ __forceinline__ const float* xrow(const Fr& F, int l, int m) {
    const int b = m / TB, t = m - b * TB;
    if (t < CTXL) return (l == 0 ? F.a->in[2] : F.ctxbuf()) + (size_t)(b * CTXL + t) * D;
    return (l == 0 ? F.a->in[0] : F.a->out) + (size_t)(b * SEQ + t - CTXL) * D;
}

struct FRkv {
    bf16* o0; bf16* o1; bf16* lm;
    __device__ __forceinline__ void operator()(const pg8::Unit& u, int rl, int cl, f32x4 v0, f32x4 v1) const {
        const int nn = u.pm / NMT, pm = u.pm - nn * NMT; const size_t row = (size_t)pm * 256 + rl;
        if (nn < 2) { const int col = (u.pn - nn * 4) * 256 + cl; store8((nn ? o1 : o0) + row * D + col, v0, v1); }
        else if (cl < 128) {
            if (nn == 2) { v0.x = tanh_fast(v0.x); v0.y = tanh_fast(v0.y); v0.z = tanh_fast(v0.z); v0.w = tanh_fast(v0.w); v1.x = tanh_fast(v1.x); v1.y = tanh_fast(v1.y); v1.z = tanh_fast(v1.z); v1.w = tanh_fast(v1.w); }
            store8(lm + row * 256 + (nn - 2) * 128 + cl, v0, v1);
        }
    }
};
struct FResid {
    const float* xo; const float* co; float* xn; float* cn; const float* modl;
    __device__ __forceinline__ void operator()(const pg8::Unit& u, int rl, int cl, f32x4 v0, f32x4 v1) const {
        const int b = u.pm / 17, j = u.pm - 17 * b, col = u.pn * 256 + cl;
        const float* src; float* dst; const float* gate;
        if (j == 0) { const size_t off = (size_t)(b * CTXL + rl) * D + col; src = co + off; dst = cn + off; gate = modl + 4 * 3072 + 2048 + col; }
        else { const size_t off = (size_t)(b * SEQ + (j - 1) * 256 + rl) * D + col; src = xo + off; dst = xn + off; gate = modl + b * 3072 + 2048 + col; }
        const f32x4 a0 = *(const f32x4*)src, a1 = *(const f32x4*)(src + 4), g0 = *(const f32x4*)gate, g1 = *(const f32x4*)(gate + 4);
        *(f32x4*)dst = a0 + g0 * v0; *(f32x4*)(dst + 4) = a1 + g1 * v1;
    }
};
struct FNaIn {
    bf16* q; bf16* k; bf16* vt; bf16* z;
    __device__ __forceinline__ void operator()(const pg8::Unit& u, int rl, int cl, f32x4 v0, f32x4 v1) const {
        const int sel = u.pn >> 2, col = (u.pn & 3) * 256 + cl; const size_t row = (size_t)u.pm * 256 + rl;
        if (sel == 2) {
            const int b = u.pm / 17, t = (u.pm - 17 * b) * 256 + rl, head = col >> 6, d = col & 63;
            bf16* p = vt + ((size_t)(b * 16 + head) * 64 + d) * TB + t;
            const unsigned w0 = pk2(v0.x, v0.y), w1 = pk2(v0.z, v0.w), w2 = pk2(v1.x, v1.y), w3 = pk2(v1.z, v1.w);
            p[0] = (bf16)w0; p[TB] = (bf16)(w0 >> 16); p[2 * TB] = (bf16)w1; p[3 * TB] = (bf16)(w1 >> 16);
            p[4 * TB] = (bf16)w2; p[5 * TB] = (bf16)(w2 >> 16); p[6 * TB] = (bf16)w3; p[7 * TB] = (bf16)(w3 >> 16);
        } else { bf16* o = q + (size_t)sel * (RSZ / 2); store8(o + row * D + col, v0, v1); }
    }
};
struct FS5In {
    bf16* uo; bf16* z;
    __device__ __forceinline__ void operator()(const pg8::Unit& u, int rl, int cl, f32x4 v0, f32x4 v1) const {
        const size_t row = (size_t)u.pm * 256 + rl;
        if (u.pn < 4) store8(uo + row * D + u.pn * 256 + cl, v0, v1);
        else store8(z + row * D + (u.pn - 4) * 256 + cl, v0, v1);
    }
};
struct FGlu {
    const bf16* y; const bf16* z; const float* bias; bf16* o;
    __device__ __forceinline__ void operator()(const pg8::Unit& u, int rl, int cl, f32x4 v0, f32x4 v1) const {
        const int col = u.pn * 256 + cl; const size_t off = ((size_t)u.pm * 256 + rl) * D + col;
        const u32x4 yw = *(const u32x4*)(y + off), zw = *(const u32x4*)(z + off);
        const f32x4 b0 = *(const f32x4*)(bias + col), b1 = *(const f32x4*)(bias + col + 4);
        f32x4 r0, r1;
        r0.x = lo_bf(yw.x) * sigm(v0.x + b0.x) * silu(lo_bf(zw.x)); r0.y = hi_bf(yw.x) * sigm(v0.y + b0.y) * silu(hi_bf(zw.x));
        r0.z = lo_bf(yw.y) * sigm(v0.z + b0.z) * silu(lo_bf(zw.y)); r0.w = hi_bf(yw.y) * sigm(v0.w + b0.w) * silu(hi_bf(zw.y));
        r1.x = lo_bf(yw.z) * sigm(v1.x + b1.x) * silu(lo_bf(zw.z)); r1.y = hi_bf(yw.z) * sigm(v1.y + b1.y) * silu(hi_bf(zw.z));
        r1.z = lo_bf(yw.w) * sigm(v1.z + b1.z) * silu(lo_bf(zw.w)); r1.w = hi_bf(yw.w) * sigm(v1.w + b1.w) * silu(hi_bf(zw.w));
        store8(o + off, r0, r1);
    }
};

template <class F> __device__ __forceinline__ void run_gemm(const Fr& Fm, const bf16* A, const bf16* Bt, int K, int nunits, int mode, int nN, const F& f) {
    pg8::Gemm g{A, Bt, 0, 0, K}; const int bx = (int)blockIdx.x, cxcd = (gridDim.x == 256) ? (bx & 7) * 32 + (bx >> 3) : bx;
    pg8::ListOrder S{nunits, (int)gridDim.x, cxcd, mode, nN}; pg8::EpiT<F> E{f};
    pg8::gemm_phase<pg8::EpiT<F>, pg8::ListOrder, true, true>((PG8_LAS unsigned char*)Fm.lds, g, S, E);
}

__device__ __forceinline__ void transpose_item(const float* W, int K, int N, bf16* WT, int row_off, float* scr, int item, int lane) {
    const int nblk = N / 32, kb = item / nblk, nb = item % nblk, k0 = 64 * kb, n0 = 32 * nb;
    f32x4 v[8];
#pragma unroll
    for (int i = 0; i < 8; ++i) v[i] = *(const f32x4*)(W + (size_t)(k0 + 8 * i + (lane >> 3)) * N + n0 + 4 * (lane & 7));
#pragma unroll
    for (int i = 0; i < 8; ++i) { float* d = scr + (8 * i + (lane >> 3)) * 33 + 4 * (lane & 7); d[0] = v[i].x; d[1] = v[i].y; d[2] = v[i].z; d[3] = v[i].w; }
    asm volatile("s_waitcnt lgkmcnt(0)" ::: "memory");
    const int c = lane & 7;
#pragma unroll
    for (int j = 0; j < 4; ++j) { const int n = (lane >> 3) + 8 * j; const float* s = scr + (8 * c) * 33 + n;
        u32x4 o; o.x = pk2(s[0 * 33], s[1 * 33]); o.y = pk2(s[2 * 33], s[3 * 33]); o.z = pk2(s[4 * 33], s[5 * 33]); o.w = pk2(s[6 * 33], s[7 * 33]);
        *(u32x4*)(WT + (size_t)(row_off + n0 + n) * K + k0 + 8 * c) = o; }
    asm volatile("s_waitcnt lgkmcnt(0)" ::: "memory");
}
__device__ __forceinline__ void conv_mat(const Fr& F, const float* W, int K, int N, bf16* WT, int row_off, int w0 = -2, int nw = GRID * NWAVES) {
    if (w0 == -2) w0 = F.gw;
    if (w0 < 0) return;
    float* scr = (float*)(F.lds + F.wave * 16384);
    const int nitems = (K / 64) * (N / 32);
    for (int it = w0; it < nitems; it += nw) transpose_item(W, K, N, WT, row_off, scr, it, F.lane);
}
__device__ __forceinline__ void conv_rwkv(const Fr& F, int j, bf16* wt, int w0 = -2, int nw = GRID * NWAVES) {
    const float* rkvg = F.a->in[8] + (size_t)j * 4 * D * D;
    conv_mat(F, rkvg, D, D, wt, 0, w0, nw); conv_mat(F, rkvg + (size_t)D * D, D, D, wt, 1024, w0, nw);
    conv_mat(F, rkvg + (size_t)2 * D * D, D, D, wt, 2560, w0, nw); conv_mat(F, rkvg + (size_t)3 * D * D, D, D, wt, 3584, w0, nw);
    for (int s = 0; s < 2; ++s) {
        conv_mat(F, F.a->in[10] + (size_t)(j * 2 + s) * D * 64, D, 64, wt, 2048 + 64 * s, w0, nw);
        conv_mat(F, F.a->in[13] + (size_t)(j * 2 + s) * D * 64, D, 64, wt, 2304 + 64 * s, w0, nw);
        conv_mat(F, F.a->in[11] + (size_t)(j * 2 + s) * 64 * D, 64, D, (bf16*)(F.ws + OFF_L2T) + (size_t)s * D * 64, 0, w0, nw);
        conv_mat(F, F.a->in[14] + (size_t)(j * 2 + s) * 64 * D, 64, D, (bf16*)(F.ws + OFF_L2T) + (size_t)(2 + s) * D * 64, 0, w0, nw);
    }
    conv_mat(F, F.a->in[20] + (size_t)j * D * D, D, D, wt, 4608, w0, nw);
}

__device__ __forceinline__ void phase_mod(const Fr& F) {
    float* sc = (float*)F.lds;
    float* red = sc + 5120;
    for (int i = F.tid; i < 5120; i += NTHR) { const int j = i >> 10, k = i & 1023; const float v = j < 4 ? F.a->in[1][j * D + k] : F.a->in[3][k]; sc[i] = silu(v); }
    __syncthreads();
    for (int task = blockIdx.x; task < 192; task += gridDim.x) {
        const int l = task / 48, n0 = (task - l * 48) * 64;
        const float* wm = F.a->in[5] + (size_t)l * D * 3072 + n0 + F.lane;
        float acc[5] = {0.f, 0.f, 0.f, 0.f, 0.f};
#pragma unroll 16
        for (int kk = 0; kk < 128; ++kk) { const int k = F.wave * 128 + kk; const float w = wm[(size_t)k * 3072];
#pragma unroll
            for (int j = 0; j < 5; ++j) acc[j] += sc[j * 1024 + k] * w; }
#pragma unroll
        for (int j = 0; j < 5; ++j) red[(F.wave * 5 + j) * 64 + F.lane] = acc[j];
        __syncthreads();
        if (F.tid < 320) { const int j = F.tid >> 6, ln = F.tid & 63; float s = F.a->in[6][l * 3072 + n0 + ln];
            for (int w = 0; w < 8; ++w) s += red[(w * 5 + j) * 64 + ln];
            F.mod(l)[j * 3072 + n0 + ln] = s; }
        __syncthreads();
    }
}

template <int NR> __device__ __forceinline__ void load_rows(const Fr& F, int l, int m0, int mlo, int mhi, f32x4 (&h)[NR][4]) {
#pragma unroll
    for (int r = 0; r < NR; ++r) {
        const int m = m0 + r; const bool valid = m >= mlo && m < mhi;
        const f32x4* xr = (const f32x4*)xrow(F, l, valid ? m : mlo) + F.lane;
#pragma unroll
        for (int j = 0; j < 4; ++j) h[r][j] = valid ? xr[64 * j] : (f32x4){0.f, 0.f, 0.f, 0.f};
    }
}
template <int NR> __device__ __forceinline__ void norm_rows(const Fr& F, int l, int m0, f32x4 (&h)[NR][4]) {
    const int b = m0 / TB, t = m0 - b * TB; const float* md = F.mod(l) + (t < CTXL ? 4 : b) * 3072;
    f32x4 gs[4], sh[4];
#pragma unroll
    for (int j = 0; j < 4; ++j) { const f32x4 g = ((const f32x4*)(F.a->in[4] + l * D) + F.lane)[64 * j], sc = ((const f32x4*)(md + 1024) + F.lane)[64 * j]; gs[j] = g * (sc + 1.f); sh[j] = ((const f32x4*)md + F.lane)[64 * j]; }
    float ss[NR];
#pragma unroll
    for (int r = 0; r < NR; ++r) { ss[r] = 0.f;
#pragma unroll
        for (int j = 0; j < 4; ++j) ss[r] += (h[r][j].x * h[r][j].x + h[r][j].y * h[r][j].y) + (h[r][j].z * h[r][j].z + h[r][j].w * h[r][j].w); }
#pragma unroll
    for (int r = 0; r < NR; ++r) { const float rstd = 1.f / sqrtf(wave_sum(ss[r]) * (1.f / D) + 1e-6f);
#pragma unroll
        for (int j = 0; j < 4; ++j) h[r][j] = (h[r][j] * rstd) * gs[j] + sh[j]; }
}
__device__ __forceinline__ void store_row_bf16(bf16* orow, int lane, const f32x4 (&v)[4]) {
    u32x2* o = (u32x2*)orow + lane;
#pragma unroll
    for (int j = 0; j < 4; ++j) { u32x2 w; w.x = pk2(v[j].x, v[j].y); w.y = pk2(v[j].z, v[j].w); o[64 * j] = w; }
}
__device__ __forceinline__ void phase_norm_plain(const Fr& F, int l) {
    for (int run = F.gw; run < NT / 4; run += GRID * NWAVES) {
        const int m0 = run * 4; f32x4 h[4][4];
        load_rows<4>(F, l, m0, 0, NT, h); norm_rows<4>(F, l, m0, h);
#pragma unroll
        for (int r = 0; r < 4; ++r) store_row_bf16(F.R(0) + (size_t)(m0 + r) * D, F.lane, h[r]);
    }
}
__device__ __forceinline__ void phase_norm_mix(const Fr& F, int l, int jr, int nmix, int n0, int n1, int n2, int n3) {
    const int nidx[4] = {n0, n1, n2, n3};
    for (int run = F.gw; run < NT / 4; run += GRID * NWAVES) {
        const int m0 = run * 4, b = m0 / TB, t0 = m0 - b * TB, seg_lo = b * TB + (t0 < CTXL ? 0 : CTXL), seg_hi = b * TB + (t0 < CTXL ? CTXL : TB);
        f32x4 h[6][4];
        load_rows<6>(F, l, m0 - 1, seg_lo, seg_hi, h); norm_rows<6>(F, l, m0, h);
        if (m0 - 1 < seg_lo) {
#pragma unroll
            for (int j = 0; j < 4; ++j) h[0][j] = (f32x4){0.f, 0.f, 0.f, 0.f}; }
        if (m0 + 4 >= seg_hi) {
#pragma unroll
            for (int j = 0; j < 4; ++j) h[5][j] = (f32x4){0.f, 0.f, 0.f, 0.f}; }
#pragma unroll
        for (int q = 0; q < 4; ++q) if (q < nmix) {
            f32x4 mu[4];
#pragma unroll
            for (int j = 0; j < 4; ++j) mu[j] = ((const f32x4*)(F.a->in[7] + (size_t)(jr * 6 + nidx[q]) * D) + F.lane)[64 * j];
#pragma unroll
            for (int r = 0; r < 4; ++r) { f32x4 o[4];
#pragma unroll
                for (int j = 0; j < 4; ++j) o[j] = h[r + 1][j] + ((h[r][j] + h[r + 2][j]) * 0.5f - h[r + 1][j]) * mu[j];
                store_row_bf16(F.R(q) + (size_t)(m0 + r) * D, F.lane, o); }
        }
    }
}

typedef float f32x2 __attribute__((ext_vector_type(2)));
#define LDS_BAR() asm volatile("s_waitcnt lgkmcnt(0)\n\ts_barrier" ::: "memory")
__device__ __forceinline__ void phase_rwkv_scan(const Fr& F, int jr) {
    float* Wv = (float*)F.lds; float* KK = Wv + 4096; float* Bv = KK + 4096; float* KD = Bv + 4096; float* Rr = KD + 4096; float* Av = Rr + 4096;
    float* Vv = Av + 8192; float* Yp = Av;
    const bf16* Rb = F.R(4); const bf16* Kb = F.R(5); const bf16* Vb = F.R(2); const bf16* LM = F.R(6);
    const bf16* L2T = (const bf16*)(F.ws + OFF_L2T);
    const int lane = F.lane, wave = F.wave, tid = F.tid, l15 = lane & 15, lq = lane >> 4;
    const int bxs = (int)blockIdx.x, bxcd = (gridDim.x == 256) ? (bxs & 7) * 32 + (bxs >> 3) : bxs;
    for (int task = bxcd; task < 256; task += gridDim.x) {
        const int half = task & 1, h = (task >> 1) & 15, b = (task >> 5) & 3, s = task >> 7;
        bf16* Yb = F.R(s);
        const float* w0 = F.a->in[9] + (size_t)(jr * 2 + s) * D + h * 64; const float* a0 = F.a->in[12] + (size_t)(jr * 2 + s) * D + h * 64;
        const float* kkw = F.a->in[15] + (size_t)jr * D + h * 64; const float* kaw = F.a->in[16] + (size_t)jr * D + h * 64;
        f32x2 S01 = {0.f, 0.f}, S23 = {0.f, 0.f};
        const int ks = 4 * l15, rloc = 4 * wave + lq;
        const int pt = wave & 3, ht0 = (wave >> 2) * 2;
        const int p1 = pt * 16 + l15;
        const int p2 = tid >> 3, j8 = tid & 7, hk0 = 8 * j8;
        bf16x8 Bw[2][2], Ba[2][2]; float w0v[2], a0v[2];
#pragma unroll
        for (int hh = 0; hh < 2; ++hh) { const int hk = (ht0 + hh) * 16 + l15, e = h * 64 + hk; w0v[hh] = w0[hk]; a0v[hh] = a0[hk];
#pragma unroll
            for (int kst = 0; kst < 2; ++kst) { Bw[hh][kst] = *(const bf16x8*)(L2T + ((size_t)s * D + e) * 64 + 32 * kst + 8 * lq); Ba[hh][kst] = *(const bf16x8*)(L2T + ((size_t)(2 + s) * D + e) * 64 + 32 * kst + 8 * lq); } }
        float kkc[8], kac[8], rkc[8];
#pragma unroll
        for (int i = 0; i < 8; ++i) { kkc[i] = kkw[hk0 + i]; kac[i] = kaw[hk0 + i]; rkc[i] = F.a->in[17][(size_t)jr * D + h * 64 + hk0 + i]; }
        float* Bon = (float*)(F.ws + OFF_R0 + 6 * RSZ + 16 * MiB);
        bf16x8 Aw[2], Aa[2]; u32x4 kw, rw; u32x2 vw;
        {   const size_t row1 = (size_t)b * TB + tokof(s, p1), row2 = (size_t)b * TB + tokof(s, p2);
#pragma unroll
            for (int kst = 0; kst < 2; ++kst) { Aw[kst] = *(const bf16x8*)(LM + row1 * 256 + 64 * s + 32 * kst + 8 * lq); Aa[kst] = *(const bf16x8*)(LM + row1 * 256 + 128 + 64 * s + 32 * kst + 8 * lq); }
            kw = *(const u32x4*)(Kb + row2 * D + h * 64 + hk0); rw = *(const u32x4*)(Rb + row2 * D + h * 64 + hk0); vw = *(const u32x2*)(Vb + row2 * D + h * 64 + 32 * half + 4 * j8); }
        for (int chunk = 0; chunk < TB / 64; ++chunk) {
#pragma unroll
            for (int hh = 0; hh < 2; ++hh) {
                const int hk = (ht0 + hh) * 16 + l15;
                f32x4 cw = {0.f, 0.f, 0.f, 0.f}, ca = {0.f, 0.f, 0.f, 0.f};
#pragma unroll
                for (int kst = 0; kst < 2; ++kst) { cw = __builtin_amdgcn_mfma_f32_16x16x32_bf16(Aw[kst], Bw[hh][kst], cw, 0, 0, 0); ca = __builtin_amdgcn_mfma_f32_16x16x32_bf16(Aa[kst], Ba[hh][kst], ca, 0, 0, 0); }
#pragma unroll
                for (int reg = 0; reg < 4; ++reg) { const int pp = pt * 16 + lq * 4 + reg;
                    Wv[pp * 64 + hk] = __expf(-0.60653066f * sigm(w0v[hh] + cw[reg]));
                    Av[pp * 64 + hk] = sigm(a0v[hh] + ca[reg]); }
            }
            LDS_BAR();
            {
                const float kr[8] = {lo_bf(kw.x), hi_bf(kw.x), lo_bf(kw.y), hi_bf(kw.y), lo_bf(kw.z), hi_bf(kw.z), lo_bf(kw.w), hi_bf(kw.w)};
                const float rr[8] = {lo_bf(rw.x), hi_bf(rw.x), lo_bf(rw.y), hi_bf(rw.y), lo_bf(rw.z), hi_bf(rw.z), lo_bf(rw.w), hi_bf(rw.w)};
                float kq[8]; float ss = 0.f, bon = 0.f;
#pragma unroll
                for (int i = 0; i < 8; ++i) { kq[i] = kr[i] * kkc[i]; ss += kq[i] * kq[i]; bon += rr[i] * kr[i] * rkc[i]; }
                ss += dppf<0xB1>(ss); ss += dppf<0x4E>(ss); ss += dppf<0x141>(ss); bon += dppf<0xB1>(bon); bon += dppf<0x4E>(bon); bon += dppf<0x141>(bon);
                if (s == 0 && half == 0 && j8 == 0) Bon[((size_t)b * TB + tokof(s, chunk * 64 + p2)) * 16 + h] = bon;
                const float inv = 1.f / fmaxf(sqrtf(ss), 1e-12f);
                const f32x4 av0 = *(const f32x4*)(Av + p2 * 64 + hk0), av1 = *(const f32x4*)(Av + p2 * 64 + hk0 + 4);
                const float av[8] = {av0.x, av0.y, av0.z, av0.w, av1.x, av1.y, av1.z, av1.w};
                float o1[8], o2[8], o3[8];
#pragma unroll
                for (int i = 0; i < 8; ++i) { const float kkv = kq[i] * inv; o1[i] = kkv; o2[i] = kkv * av[i]; o3[i] = kr[i] * (1.f + (av[i] - 1.f) * kac[i]); }
                const int o = p2 * 64 + hk0;
                *(f32x4*)(KK + o) = (f32x4){o1[0], o1[1], o1[2], o1[3]}; *(f32x4*)(KK + o + 4) = (f32x4){o1[4], o1[5], o1[6], o1[7]};
                *(f32x4*)(Bv + o) = (f32x4){o2[0], o2[1], o2[2], o2[3]}; *(f32x4*)(Bv + o + 4) = (f32x4){o2[4], o2[5], o2[6], o2[7]};
                *(f32x4*)(KD + o) = (f32x4){o3[0], o3[1], o3[2], o3[3]}; *(f32x4*)(KD + o + 4) = (f32x4){o3[4], o3[5], o3[6], o3[7]};
                *(f32x4*)(Rr + o) = (f32x4){rr[0], rr[1], rr[2], rr[3]}; *(f32x4*)(Rr + o + 4) = (f32x4){rr[4], rr[5], rr[6], rr[7]};
                *(f32x4*)(Vv + p2 * 32 + 4 * j8) = (f32x4){lo_bf(vw.x), hi_bf(vw.x), lo_bf(vw.y), hi_bf(vw.y)};
            }
            if (chunk + 1 < TB / 64) {
                const size_t row1 = (size_t)b * TB + tokof(s, (chunk + 1) * 64 + p1), row2 = (size_t)b * TB + tokof(s, (chunk + 1) * 64 + p2);
#pragma unroll
                for (int kst = 0; kst < 2; ++kst) { Aw[kst] = *(const bf16x8*)(LM + row1 * 256 + 64 * s + 32 * kst + 8 * lq); Aa[kst] = *(const bf16x8*)(LM + row1 * 256 + 128 + 64 * s + 32 * kst + 8 * lq); }
                kw = *(const u32x4*)(Kb + row2 * D + h * 64 + hk0); rw = *(const u32x4*)(Rb + row2 * D + h * 64 + hk0); vw = *(const u32x2*)(Vb + row2 * D + h * 64 + 32 * half + 4 * j8);
            }
            LDS_BAR();
            {
                float* Ypw = Yp + wave * 1024;
                unsigned a1 = (unsigned)(size_t)(__attribute__((address_space(3))) float*)(Wv + ks), a2 = (unsigned)(size_t)(__attribute__((address_space(3))) float*)(Rr + ks),
                         a3 = (unsigned)(size_t)(__attribute__((address_space(3))) float*)(Vv + rloc), a4 = (unsigned)(size_t)(__attribute__((address_space(3))) float*)(Ypw + lane);
                asm volatile("" : "+v"(a1), "+v"(a2), "+v"(a3), "+v"(a4));
                typedef const __attribute__((address_space(3))) f32x4* lp4; typedef const __attribute__((address_space(3))) float* lp1; typedef __attribute__((address_space(3))) float* lw1;
                const lp4 PW = (lp4)a1, PR = (lp4)a2; const lp1 PV = (lp1)a3; const lw1 PY = (lw1)a4;
                f32x4 w4 = PW[0], k4 = PW[1024], b4 = PW[2048], d4 = PW[3072], r4 = PR[0];
                float vv = PV[0];
                for (int pg = 0; pg < 64; pg += 16) {
#pragma unroll
                    for (int pi = 0; pi < 16; ++pi) {
                        const int p = pg + pi, pn = p < 63 ? p + 1 : 63;
                        const f32x4 w4n = PW[pn * 16], k4n = PW[1024 + pn * 16], b4n = PW[2048 + pn * 16], d4n = PW[3072 + pn * 16], r4n = PR[pn * 16];
                        const float vvn = PV[pn * 32];
                        f32x2 t = S01 * k4.xy; t = S23 * k4.zw + t; float sa = t.x + t.y;
                        sa += dppf<0x128>(sa);
                        const f32x2 dv01 = d4.xy * vv, dv23 = d4.zw * vv;
                        sa += dppf<0x124>(sa);
                        const f32x2 e01 = S01 * w4.xy + dv01;
                        sa += dppf<0x122>(sa);
                        const f32x2 e23 = S23 * w4.zw + dv23;
                        sa += dppf<0x121>(sa);
                        S01 = e01 - b4.xy * sa; S23 = e23 - b4.zw * sa;
                        f32x2 u = S01 * r4.xy; u = S23 * r4.zw + u;
                        PY[pi * 64] = u.x + u.y;
                        w4 = w4n; k4 = k4n; b4 = b4n; d4 = d4n; r4 = r4n; vv = vvn;
                    }
                    asm volatile("s_waitcnt lgkmcnt(0)" ::: "memory");
                    {
                        const int j = lane >> 2, q = lane & 3; const float* yp = Ypw + j * 64 + q * 16;
                        const f32x4 a0 = *(const f32x4*)yp, a1 = *(const f32x4*)(yp + 4), a2 = *(const f32x4*)(yp + 8), a3 = *(const f32x4*)(yp + 12);
                        const f32x4 ssum = (a0 + a1) + (a2 + a3); const float yv = (ssum.x + ssum.y) + (ssum.z + ssum.w);
                        const size_t row = (size_t)b * TB + tokof(s, chunk * 64 + pg + j);
                        Yb[row * D + h * 64 + 32 * half + 4 * wave + q] = (bf16)f2bf(yv);
                    }
                    asm volatile("s_waitcnt lgkmcnt(0)" ::: "memory");
                }
            }
            LDS_BAR();
        }
        LDS_BAR();
    }
}

__device__ __forceinline__ void phase_rwkv_post(const Fr& F, int jr) {
    const float* lnw = F.a->in[18] + (size_t)jr * D; const float* lnb = F.a->in[19] + (size_t)jr * D;
    const float* Bon = (const float*)(F.ws + OFF_R0 + 6 * RSZ + 16 * MiB);
    for (int m = F.gw; m < NT; m += GRID * NWAVES) {
        const size_t base = (size_t)m * D;
        u32x2 ow[4];
#pragma unroll
        for (int j = 0; j < 4; ++j) {
            const int c = 256 * j + 4 * F.lane;
            const u32x2 y0 = *(const u32x2*)(F.R(0) + base + c), y1 = *(const u32x2*)(F.R(1) + base + c), vw = *(const u32x2*)(F.R(2) + base + c), gw = *(const u32x2*)(F.R(3) + base + c);
            const float bsum = Bon[(size_t)m * 16 + 4 * j + (F.lane >> 4)];
            float y[4] = {lo_bf(y0.x) + lo_bf(y1.x), hi_bf(y0.x) + hi_bf(y1.x), lo_bf(y0.y) + lo_bf(y1.y), hi_bf(y0.y) + hi_bf(y1.y)};
            const float v[4] = {lo_bf(vw.x), hi_bf(vw.x), lo_bf(vw.y), hi_bf(vw.y)}, g[4] = {lo_bf(gw.x), hi_bf(gw.x), lo_bf(gw.y), hi_bf(gw.y)};
            const f32x4 lw = *(const f32x4*)(lnw + c), lb = *(const f32x4*)(lnb + c);
            const float mean = allred16((y[0] + y[1]) + (y[2] + y[3])) * (1.f / 64.f);
            float q = 0.f;
#pragma unroll
            for (int i = 0; i < 4; ++i) { y[i] -= mean; q += y[i] * y[i]; }
            const float rstd = 1.f / sqrtf(allred16(q) * (1.f / 64.f) + 64e-5f);
            float o[4];
#pragma unroll
            for (int i = 0; i < 4; ++i) o[i] = (y[i] * rstd * lw[i] + lb[i] + bsum * v[i]) * silu(g[i]);
            ow[j].x = pk2(o[0], o[1]); ow[j].y = pk2(o[2], o[3]);
        }
#pragma unroll
        for (int j = 0; j < 4; ++j) *(u32x2*)(F.R(0) + base + 256 * j + 4 * F.lane) = ow[j];
    }
}

__device__ __forceinline__ void phase_na_qknorm(const Fr& F) {
    const float* qg = F.a->in[22]; const float* kg = F.a->in[23];
    const int d0 = 4 * (F.lane & 15);
    for (int m = F.gw; m < 2 * NT; m += GRID * NWAVES) {
        const int isk = m >= NT; bf16* p = F.R(1 + isk) + (size_t)(m - isk * NT) * D; const float* g = isk ? kg : qg; const float sc = isk ? 1.f : 0.125f;
#pragma unroll
        for (int j = 0; j < 4; ++j) {
            u32x2* pp = (u32x2*)(p + 256 * j + 4 * F.lane); const u32x2 w = *pp;
            float x[4] = {lo_bf(w.x), hi_bf(w.x), lo_bf(w.y), hi_bf(w.y)};
            const float ss = allred16((x[0] * x[0] + x[1] * x[1]) + (x[2] * x[2] + x[3] * x[3]));
            const float rstd = sc / sqrtf(ss * (1.f / 64.f) + 1e-6f);
            u32x2 o; o.x = pk2(x[0] * rstd * g[d0], x[1] * rstd * g[d0 + 1]); o.y = pk2(x[2] * rstd * g[d0 + 2], x[3] * rstd * g[d0 + 3]);
            *pp = o;
        }
    }
}
__device__ __forceinline__ void phase_na_attn(const Fr& F) {
    constexpr int KST = 72;
    bf16* KV = (bf16*)F.lds;
    float* rpbT = (float*)(F.lds + 36864 + 8 * 1536);
    const bf16* Qn = F.R(1); const bf16* Kn = F.R(2); const bf16* VT = F.R(3); const bf16* Z = F.R(4); bf16* Og = F.R(5);
    const int lane = F.lane, l15 = lane & 15, lq = lane >> 4, wave = F.wave, tid = F.tid;
    const int srow = tid >> 3, spart = (tid & 7) * 8;
    const int bxa = (int)blockIdx.x, bxcda = (gridDim.x == 256) ? (bxa & 7) * 32 + (bxa >> 3) : bxa;
    float kgc[8];
#pragma unroll
    for (int i = 0; i < 8; ++i) kgc[i] = F.a->in[23][spart + i];
    auto knorm = [&](u32x4 w) -> u32x4 {
        float x[8] = {lo_bf(w.x), hi_bf(w.x), lo_bf(w.y), hi_bf(w.y), lo_bf(w.z), hi_bf(w.z), lo_bf(w.w), hi_bf(w.w)};
        float ss = ((x[0] * x[0] + x[1] * x[1]) + (x[2] * x[2] + x[3] * x[3])) + ((x[4] * x[4] + x[5] * x[5]) + (x[6] * x[6] + x[7] * x[7]));
        ss += dppf<0xB1>(ss); ss += dppf<0x4E>(ss); ss += dppf<0x141>(ss);
        const float rstd = __builtin_amdgcn_rsqf(ss * (1.f / 64.f) + 1e-6f);
        u32x4 o; o.x = pk2(x[0] * rstd * kgc[0], x[1] * rstd * kgc[1]); o.y = pk2(x[2] * rstd * kgc[2], x[3] * rstd * kgc[3]); o.z = pk2(x[4] * rstd * kgc[4], x[5] * rstd * kgc[5]); o.w = pk2(x[6] * rstd * kgc[6], x[7] * rstd * kgc[7]);
        return o; };
    for (int bt = bxcda; bt < 2048 + 128; bt += gridDim.x) {
        int b, h, nrows, rlo = 0, gi = 0, q0 = 0, lo = 0, r0 = 0, qrow0;
        if (bt < 2048) { const int ip = bt & 31; h = (bt >> 5) & 15; b = bt >> 9; gi = 2 * ip + (wave >> 2); const int qt = wave & 3; q0 = 16 * qt; lo = qt == 0 ? 0 : (qt == 1 ? 8 : (qt == 2 ? 24 : 32));
            r0 = min(max(gi - 4, 0), 56); rlo = min(max(2 * ip - 4, 0), 56); nrows = min(max(2 * ip - 3, 0), 56) + 8 - rlo; qrow0 = b * TB + CTXL + gi * 64 + q0; }
        else { const int idx = bt - 2048; b = idx >> 5; h = (idx >> 1) & 15; nrows = 0; qrow0 = b * TB + 16 * (8 * (idx & 1) + wave); }
        const int ntl = nrows + 4;
        int boff[2][4];
#pragma unroll
        for (int st = 0; st < 2; ++st)
#pragma unroll
            for (int reg = 0; reg < 4; ++reg) { const int c = lo + 16 * st + 4 * lq + reg, qc = q0 + l15, cs = min(max(qc - 8, 0), 48); boff[st][reg] = (c >= cs && c < cs + 16) ? c - qc + 15 : -1; }
        __syncthreads();
        if (tid < 465) rpbT[tid] = F.a->in[24][h * 465 + tid];
        bf16x8 Qf[2];
        {
            u32x4 qw[2]; float qv[2][8]; float ss = 0.f;
#pragma unroll
            for (int ds = 0; ds < 2; ++ds) { qw[ds] = *(const u32x4*)(Qn + (size_t)(qrow0 + l15) * D + h * 64 + 32 * ds + 8 * lq);
#pragma unroll
                for (int i = 0; i < 4; ++i) { qv[ds][2 * i] = lo_bf(qw[ds][i]); qv[ds][2 * i + 1] = hi_bf(qw[ds][i]); ss += qv[ds][2 * i] * qv[ds][2 * i] + qv[ds][2 * i + 1] * qv[ds][2 * i + 1]; } }
            ss += __shfl_xor(ss, 16); ss += __shfl_xor(ss, 32);
            const float rstd = 0.125f / sqrtf(ss * (1.f / 64.f) + 1e-6f);
#pragma unroll
            for (int ds = 0; ds < 2; ++ds) { const float* qg = F.a->in[22] + 32 * ds + 8 * lq; u32x4 o;
#pragma unroll
                for (int i = 0; i < 4; ++i) o[i] = pk2(qv[ds][2 * i] * rstd * qg[2 * i], qv[ds][2 * i + 1] * rstd * qg[2 * i + 1]);
                Qf[ds] = __builtin_bit_cast(bf16x8, o); }
        }
        f32x4 O[4]; float lsum = 0.f;
#pragma unroll
        for (int dt = 0; dt < 4; ++dt) O[dt] = (f32x4){0.f, 0.f, 0.f, 0.f};
        const bf16* Kg = Kn + (size_t)b * TB * D + h * 64 + spart + (size_t)srow * D;
        const bf16* Vg = VT + ((size_t)(b * 16 + h) * 64 + srow) * TB + spart;
        u32x4 kr0, vr0, kr1, vr1;
#define NA_T0(TN) ((TN) < nrows ? CTXL + (rlo + (TN)) * 64 : 64 * ((TN) - nrows))
        { const int t0 = NA_T0(0); kr0 = *(const u32x4*)(Kg + (size_t)t0 * D); vr0 = *(const u32x4*)(Vg + t0); }
        { const int t1 = NA_T0(1); kr1 = *(const u32x4*)(Kg + (size_t)t1 * D); vr1 = *(const u32x4*)(Vg + t1); }
        *(u32x4*)(KV + srow * KST + spart) = knorm(kr0); *(u32x4*)(KV + 64 * KST + srow * KST + spart) = vr0;
        __syncthreads();
#define NA_STEP(KR_NEXT, VR_NEXT, KR_LOAD, VR_LOAD) do { \
            if (tix + 2 < ntl) { const int t2 = NA_T0(tix + 2); KR_LOAD = *(const u32x4*)(Kg + (size_t)t2 * D); VR_LOAD = *(const u32x4*)(Vg + t2); } \
            na_tile(); \
            if (tix + 1 < ntl) { bf16* Kw = KV + ((tix + 1) & 1) * (128 * KST); *(u32x4*)(Kw + srow * KST + spart) = knorm(KR_NEXT); *(u32x4*)(Kw + 64 * KST + srow * KST + spart) = VR_NEXT; } \
            __syncthreads(); } while (0)
        int tix = 0;
        auto na_tile = [&]() {
            const bf16* Kl = KV + (tix & 1) * (128 * KST); const bf16* Vl = Kl + 64 * KST;
            const bool nb = tix < nrows; const int rr = rlo + tix;
            const bool mine = nb ? (rr >= r0 && rr < r0 + 8) : true;
            if (mine) {
                const int nsub = nb ? 1 : 2;
                for (int sub = 0; sub < nsub; ++sub) {
                    const int koff = nb ? lo : 32 * sub;
                    f32x4 Sx[2];
#pragma unroll
                    for (int st = 0; st < 2; ++st) { Sx[st] = (f32x4){0.f, 0.f, 0.f, 0.f};
#pragma unroll
                        for (int ds = 0; ds < 2; ++ds) { const bf16x8 Kf = *(const bf16x8*)(Kl + (koff + 16 * st + l15) * KST + 32 * ds + 8 * lq);
                            Sx[st] = __builtin_amdgcn_mfma_f32_16x16x32_bf16(Kf, Qf[ds], Sx[st], 0, 0, 0); } }
                    float pv[2][4];
#pragma unroll
                    for (int st = 0; st < 2; ++st)
#pragma unroll
                        for (int reg = 0; reg < 4; ++reg) {
                            if (nb) { const int bo = boff[st][reg]; pv[st][reg] = bo >= 0 ? __expf(Sx[st][reg] + rpbT[(rr - gi + 7) * 31 + bo]) : 0.f; }
                            else pv[st][reg] = __expf(Sx[st][reg]); }
                    u32x4 pw; pw.x = f2bf(pv[0][0]) | (f2bf(pv[0][1]) << 16); pw.y = f2bf(pv[0][2]) | (f2bf(pv[0][3]) << 16); pw.z = f2bf(pv[1][0]) | (f2bf(pv[1][1]) << 16); pw.w = f2bf(pv[1][2]) | (f2bf(pv[1][3]) << 16);
                    lsum += ((lo_bf(pw.x) + hi_bf(pw.x)) + (lo_bf(pw.y) + hi_bf(pw.y))) + ((lo_bf(pw.z) + hi_bf(pw.z)) + (lo_bf(pw.w) + hi_bf(pw.w)));
                    const bf16x8 Pb = __builtin_bit_cast(bf16x8, pw);
#pragma unroll
                    for (int dt = 0; dt < 4; ++dt) { const bf16* vp = Vl + (16 * dt + l15) * KST + koff + 4 * lq;
                        u32x4 vw; const u32x2 v0 = *(const u32x2*)vp, v1 = *(const u32x2*)(vp + 16); vw.x = v0.x; vw.y = v0.y; vw.z = v1.x; vw.w = v1.y;
                        O[dt] = __builtin_amdgcn_mfma_f32_16x16x32_bf16(__builtin_bit_cast(bf16x8, vw), Pb, O[dt], 0, 0, 0); }
                }
            }
        };
        for (; tix + 1 < ntl; tix += 2) { NA_STEP(kr1, vr1, kr0, vr0); ++tix; NA_STEP(kr0, vr0, kr1, vr1); --tix; }
        if (tix < ntl) { NA_STEP(kr1, vr1, kr0, vr0); }
#undef NA_STEP
#undef NA_T0
        {
            float lt = lsum; lt += __shfl_xor(lt, 16); lt += __shfl_xor(lt, 32);
            const float inv = 1.f / lt; const size_t row = (size_t)(qrow0 + l15) * D + h * 64 + 4 * lq;
#pragma unroll
            for (int dt = 0; dt < 4; ++dt) { const u32x2 zw = *(const u32x2*)(Z + row + 16 * dt);
                u32x2 o; o.x = pk2(O[dt][0] * inv * silu(lo_bf(zw.x)), O[dt][1] * inv * silu(hi_bf(zw.x))); o.y = pk2(O[dt][2] * inv * silu(lo_bf(zw.y)), O[dt][3] * inv * silu(hi_bf(zw.y)));
                *(u32x2*)(Og + row + 16 * dt) = o; }
        }
    }
}

__device__ __forceinline__ void phase_s5_params(const Fr& F) {
    const int idx = blockIdx.x * NTHR + F.tid; if (idx >= 8192) return;
    const int p = idx & 63, g = (idx >> 6) & 63, s = idx >> 12;
    const float lr = F.a->in[27][idx], li = F.a->in[28][idx], step = expf(F.a->in[29][s * 64 + g]);
    const float mag = expf(lr * step), ar = mag * cosf(li * step), ai = mag * sinf(li * step), den = lr * lr + li * li;
    const float qr = ((ar - 1.f) * lr + ai * li) / den, qi = (ai * lr - (ar - 1.f) * li) / den;
    float pr = ar, pi = ai;
    for (int i = 0; i < 6; ++i) { const float nr = pr * pr - pi * pi, ni = 2.f * pr * pi; pr = nr; pi = ni; }
    float* A = (float*)(F.ws + OFF_S5A) + idx * 4; A[0] = ar; A[1] = ai; A[2] = pr; A[3] = pi;
    float* BB = (float*)(F.ws + OFF_BB) + (size_t)idx * 32;
    const float* br = F.a->in[30] + ((size_t)g * 64 + p) * 16; const float* bi = F.a->in[31] + ((size_t)g * 64 + p) * 16;
    for (int c = 0; c < 16; ++c) { BB[c] = qr * br[c] - qi * bi[c]; BB[16 + c] = qr * bi[c] + qi * br[c]; }
}
template <bool FINAL> __device__ __forceinline__ void phase_s5_scan(const Fr& F) {
    const bf16* U = F.R(1); float* E = (float*)F.R(6);
    float* BUl = (float*)(F.lds + F.wave * 16384);
    const int lane = F.lane, l15 = lane & 15, lq = lane >> 4;
    const float* BBf = (const float*)(F.ws + OFF_BB);
    const int sg = F.gw >> 4, g = sg & 63, s = sg >> 6;
    const f32x4 av = *(const f32x4*)((const float*)(F.ws + OFF_S5A) + (sg * 64 + lane) * 4);
    const float ar = av.x, ai = av.y;
    bf16x8 B1[8];
#pragma unroll
    for (int nt = 0; nt < 8; ++nt) {
        const int n = 16 * nt + l15; const float* bp = BBf + (size_t)(sg * 64 + (n & 63)) * 32 + 16 * (n >> 6) + 8 * (lq & 1);
        const f32x4 t0 = *(const f32x4*)bp, t1 = *(const f32x4*)(bp + 4); const float f[8] = {t0.x, t0.y, t0.z, t0.w, t1.x, t1.y, t1.z, t1.w};
        B1[nt] = lq < 2 ? pack8(f) : (bf16x8){0, 0, 0, 0, 0, 0, 0, 0};
    }
    bf16x8 Chi[4];
    if (FINAL) {
#pragma unroll
        for (int ks = 0; ks < 4; ++ks) {
            const int k = 32 * ks + 8 * lq; const float* cp = (k < 64 ? F.a->in[32] : F.a->in[33]) + (size_t)g * 1024 + l15 * 64 + (k & 63); const float sg_ = k < 64 ? 1.f : -1.f;
            const f32x4 t0 = *(const f32x4*)cp, t1 = *(const f32x4*)(cp + 4); const float f[8] = {sg_ * t0.x, sg_ * t0.y, sg_ * t0.z, sg_ * t0.w, sg_ * t1.x, sg_ * t1.y, sg_ * t1.z, sg_ * t1.w};
            Chi[ks] = pack8(f);
        }
    }
    u32x4 ua[4]; float e0 = 0.f, e1 = 0.f;
    {   const int ti = F.gw & 15, b = ti / 68, chunk = ti - b * 68;
#pragma unroll
        for (int sb = 0; sb < 4; ++sb) ua[sb] = lq < 2 ? *(const u32x4*)(U + ((size_t)b * TB + tokof(s, chunk * 64 + sb * 16 + l15)) * D + g * 16 + 8 * lq) : (u32x4){0u, 0u, 0u, 0u};
        if (FINAL) { const float* e = E + ((size_t)(((s * 4 + b) * 64 + g) * 68 + chunk) * 64 + lane) * 2; e0 = e[0]; e1 = e[1]; } }
    for (int ti = (F.gw & 15); ti < NB * 68; ti += 16) {
        const int b = ti / 68, chunk = ti - b * 68, sbg = (s * 4 + b) * 64 + g, task = sbg * 68 + chunk;
        float xr = FINAL ? e0 : 0.f, xi = FINAL ? e1 : 0.f;
        bf16* Yb = F.R(4 + s);
        u32x4 uc[4];
#pragma unroll
        for (int sb = 0; sb < 4; ++sb) uc[sb] = ua[sb];
        if (ti + 16 < NB * 68) {
            const int tn = ti + 16, bn = tn / 68, cn = tn - bn * 68;
#pragma unroll
            for (int sb = 0; sb < 4; ++sb) ua[sb] = lq < 2 ? *(const u32x4*)(U + ((size_t)bn * TB + tokof(s, cn * 64 + sb * 16 + l15)) * D + g * 16 + 8 * lq) : (u32x4){0u, 0u, 0u, 0u};
            if (FINAL) { const float* e = E + ((size_t)(((s * 4 + bn) * 64 + g) * 68 + cn) * 64 + lane) * 2; e0 = e[0]; e1 = e[1]; }
        }
#pragma unroll
        for (int sub = 0; sub < 4; ++sub) {
            const bf16x8 A1 = __builtin_bit_cast(bf16x8, uc[sub]);
#pragma unroll
            for (int nt = 0; nt < 8; ++nt) {
                f32x4 acc = {0.f, 0.f, 0.f, 0.f};
                acc = __builtin_amdgcn_mfma_f32_16x16x32_bf16(A1, B1[nt], acc, 0, 0, 0);
#pragma unroll
                for (int reg = 0; reg < 4; ++reg) BUl[(4 * lq + reg) * 132 + 16 * nt + l15] = acc[reg];
            }
            asm volatile("s_waitcnt lgkmcnt(0)" ::: "memory");
#pragma unroll 4
            for (int jj = 0; jj < 16; ++jj) {
                const float br_ = BUl[jj * 132 + lane], bi_ = BUl[jj * 132 + 64 + lane];
                const float nr = ar * xr - ai * xi + br_, ni = ar * xi + ai * xr + bi_; xr = nr; xi = ni;
                if (FINAL) { BUl[jj * 132 + lane] = xr; BUl[jj * 132 + 64 + lane] = xi; }
            }
            if (FINAL) {
                asm volatile("s_waitcnt lgkmcnt(0)" ::: "memory");
                f32x4 acc = {0.f, 0.f, 0.f, 0.f};
#pragma unroll
                for (int ks = 0; ks < 4; ++ks) {
                    const f32x4 t0 = *(const f32x4*)(BUl + l15 * 132 + 32 * ks + 8 * lq), t1 = *(const f32x4*)(BUl + l15 * 132 + 32 * ks + 8 * lq + 4);
                    const float xf[8] = {t0.x, t0.y, t0.z, t0.w, t1.x, t1.y, t1.z, t1.w};
                    acc = __builtin_amdgcn_mfma_f32_16x16x32_bf16(pack8(xf), Chi[ks], acc, 0, 0, 0);
                }
#pragma unroll
                for (int reg = 0; reg < 4; ++reg) { const int tok = tokof(s, chunk * 64 + sub * 16 + 4 * lq + reg);
                    Yb[((size_t)b * TB + tok) * D + g * 16 + l15] = (bf16)f2bf(acc[reg]); }
                asm volatile("s_waitcnt lgkmcnt(0)" ::: "memory");
            }
        }
        if (!FINAL) { float* e = E + ((size_t)task * 64 + lane) * 2; e[0] = xr; e[1] = xi; }
    }
}
__device__ __forceinline__ void phase_s5_carry(const Fr& F) {
    const int idx = blockIdx.x * NTHR + F.tid; if (idx >= 2 * NB * 64 * 64) return;
    const int p = idx & 63, sbg = idx >> 6, g = sbg & 63, s = sbg >> 8;
    const f32x4 av = *(const f32x4*)((const float*)(F.ws + OFF_S5A) + ((s * 64 + g) * 64 + p) * 4);
    float* E = (float*)F.R(6) + ((size_t)sbg * 68 * 64 + p) * 2;
    float er[68], ei[68];
#pragma unroll
    for (int c = 0; c < 68; ++c) { er[c] = E[(size_t)c * 128]; ei[c] = E[(size_t)c * 128 + 1]; }
    float cr = 0.f, ci = 0.f;
#pragma unroll
    for (int c = 0; c < 68; ++c) { E[(size_t)c * 128] = cr; E[(size_t)c * 128 + 1] = ci;
        const float nr = av.z * cr - av.w * ci + er[c], ni = av.z * ci + av.w * cr + ei[c]; cr = nr; ci = ni; }
}
__device__ __forceinline__ void phase_s5_combine(const Fr& F) {
    const bf16* U = F.R(1); const float* dsk = F.a->in[34];
    for (size_t i = (size_t)blockIdx.x * NTHR + F.tid; i < (size_t)NT * D / 4; i += (size_t)GRID * NTHR) {
        const size_t e = i * 4; const int c = (int)(e & 1023);
        const u32x2 y0 = *(const u32x2*)(F.R(4) + e), y1 = *(const u32x2*)(F.R(5) + e), uw = *(const u32x2*)(U + e); const f32x4 d = *(const f32x4*)(dsk + c);
        float y[4] = {lo_bf(y0.x) + lo_bf(y1.x) + d.x * lo_bf(uw.x), hi_bf(y0.x) + hi_bf(y1.x) + d.y * hi_bf(uw.x), lo_bf(y0.y) + lo_bf(y1.y) + d.z * lo_bf(uw.y), hi_bf(y0.y) + hi_bf(y1.y) + d.w * hi_bf(uw.y)};
#pragma unroll
        for (int k = 0; k < 4; ++k) { const float x = y[k]; y[k] = 0.5f * x * (1.f + tanh_fast(0.7978845608f * (x + 0.044715f * x * x * x))); }
        u32x2 o; o.x = pk2(y[0], y[1]); o.y = pk2(y[2], y[3]); *(u32x2*)(F.R(0) + e) = o;
    }
}

#define LAS __attribute__((address_space(3)))
#define XB_TMO      128
#define XB_XCNT(j)  (256  + 64 * (j))
#define XB_XSUB(j)  (1280 + 64 * (j))
#define XB_XGEN(j)  (2304 + 64 * (j))
#define XB_TOP      3328
#define XB_TOPGEN   3392
#define XCD_BAR_WORDS 3456
#define XB_SPIN_CAP (1u << 18)

__device__ __forceinline__ unsigned xb_ld(unsigned* p)              { return __hip_atomic_load(p, __ATOMIC_RELAXED, __HIP_MEMORY_SCOPE_AGENT); }
__device__ __forceinline__ unsigned xb_add(unsigned* p, unsigned v) { return __hip_atomic_fetch_add(p, v, __ATOMIC_RELAXED, __HIP_MEMORY_SCOPE_AGENT); }
__device__ __forceinline__ unsigned xb_xcc_id() { return (unsigned)__builtin_amdgcn_s_getreg((3 << 11) | 20) & 0xFu; }
#define XB_SPIN(cond, bar) do { unsigned _sp = 0; while (cond) { __builtin_amdgcn_s_sleep(1); \
    if ((++_sp & 255u) == 0u) { if (xb_ld(&(bar)[XB_TMO])) break; if (_sp > XB_SPIN_CAP) { atomicAdd(&(bar)[XB_TMO], 1u); break; } } } } while (0)

struct XcdBarrier {
    unsigned* bar; unsigned x;
    volatile LAS unsigned* st;
};

__device__ __forceinline__ XcdBarrier xcd_barrier_post(unsigned* bar, volatile LAS unsigned* st) {
    XcdBarrier b; b.bar = bar; b.x = xb_xcc_id(); b.st = st;
    if (threadIdx.x == 0) (void)xb_add(&bar[XB_XCNT(b.x)], 1u);
    return b;
}
__device__ __forceinline__ void xcd_barrier_complete(unsigned* bar, unsigned x, unsigned& nloc, unsigned& nx) {
    const unsigned G = gridDim.x * gridDim.y * gridDim.z;
    unsigned sum, cnt, mine, sp = 0u;
    for (;;) {
        sum = 0u; cnt = 0u; mine = 0u;
#pragma unroll
        for (unsigned j = 0; j < 16; ++j) { const unsigned c = xb_ld(&bar[XB_XCNT(j)]); sum += c; cnt += (c > 0u) ? 1u : 0u; mine = (j == x) ? c : mine; }
        if (sum == G) break;
        __builtin_amdgcn_s_sleep(1);
        if ((++sp & 255u) == 0u) { if (xb_ld(&bar[XB_TMO])) break; if (sp > XB_SPIN_CAP) { atomicAdd(&bar[XB_TMO], 1u); break; } }
    }
    nloc = mine > 0u ? mine : 1u; nx = cnt > 0u ? cnt : 1u;
}

__device__ __forceinline__ void xcd_barrier(const XcdBarrier& b) {
    asm volatile("s_waitcnt vmcnt(0)" ::: "memory");
    __syncthreads();
    if (threadIdx.x == 0) {
        unsigned* bar = b.bar;
        __builtin_amdgcn_s_waitcnt(0);
        unsigned nloc = b.st[0], nx = b.st[1];
        if (nloc == 0u) { xcd_barrier_complete(bar, b.x, nloc, nx); b.st[0] = nloc; b.st[1] = nx; }
        const unsigned old = xb_add(&bar[XB_XSUB(b.x)], 1u);
        const unsigned gen = old / nloc;
        if (old + 1u == (gen + 1u) * nloc) {
            __builtin_amdgcn_fence(__ATOMIC_RELEASE, "agent");
            asm volatile("s_waitcnt vmcnt(0)" ::: "memory");
            const unsigned og = xb_add(&bar[XB_TOP], 1u);
            const unsigned tg = og / nx;
            if (og + 1u == (tg + 1u) * nx) xb_add(&bar[XB_TOPGEN], 1u);
            else XB_SPIN(xb_ld(&bar[XB_TOPGEN]) == tg, bar);
            __builtin_amdgcn_fence(__ATOMIC_ACQUIRE, "agent");
            xb_add(&bar[XB_XGEN(b.x)], 1u);
            asm volatile("s_waitcnt vmcnt(0)" ::: "memory");
        } else {
            XB_SPIN(xb_ld(&bar[XB_XGEN(b.x)]) == gen, bar);
            __builtin_amdgcn_fence(__ATOMIC_ACQUIRE, "agent");
            asm volatile("s_waitcnt vmcnt(0)" ::: "memory");
        }
    }
    __syncthreads();
}

constexpr int NPHASE = 28;
#ifndef PROBE_MASK
#define PROBE_MASK 0
#endif
__device__ __forceinline__ void phase_na_qknorm_dummy(const Fr& F) {}

#define PH(k) if (args.ph_lo <= (k) && (k) < args.ph_hi)
#define SEAM(k) if (args.ph_lo <= (k) && (k) + 1 < args.ph_hi) { if ((k) == 0) grid.sync(); else { xcd_barrier(bar); if (PROBE_MASK & 32) { xcd_barrier(bar); xcd_barrier(bar); } } }
#define RWKV_LAYER(P0, L, JR, XO, CO, OUTN, OUTMODE, NEXTCONV) \
    PH(P0 + 0) { phase_norm_mix(F, L, JR, 4, 0, 1, 4, 5); } SEAM(P0 + 0); \
    if (PROBE_MASK & 8) { phase_norm_mix(F, L, JR, 4, 0, 1, 4, 5); xcd_barrier(bar); } \
    PH(P0 + 1) { run_gemm(F, F.R(0), F.WTb(L), D, 680, 1, 0, FRkv{F.R(4), F.R(5), F.R(6)}); } SEAM(P0 + 1); \
    if (PROBE_MASK & 16) { run_gemm(F, F.R(0), F.WTb(L), D, 680, 1, 0, FRkv{F.R(4), F.R(5), F.R(6)}); xcd_barrier(bar); } \
    PH(P0 + 2) { phase_norm_mix(F, L, JR, 2, 2, 3, 0, 0); } SEAM(P0 + 2); \
    PH(P0 + 3) { run_gemm(F, F.R(0), F.WTb(L) + (size_t)2560 * D, D, 544, 2, 0, FRkv{F.R(2), F.R(3), nullptr}); } SEAM(P0 + 3); \
    PH(P0 + 4) { phase_rwkv_scan(F, JR); } SEAM(P0 + 4); \
    if (PROBE_MASK & 1) { phase_rwkv_scan(F, JR); xcd_barrier(bar); } \
    PH(P0 + 5) { phase_rwkv_post(F, JR); } SEAM(P0 + 5); \
    PH(P0 + 6) { run_gemm(F, F.R(0), F.WTb(L) + (size_t)4608 * D, D, OUTN, OUTMODE, 4, FResid{XO, CO, args.out, F.ctxbuf(), F.mod(L)}); NEXTCONV; } SEAM(P0 + 6);
__global__ void __launch_bounds__(NTHR) fwd_kernel(Args args) {
    extern __shared__ __attribute__((aligned(16))) unsigned char lds[];
    cg::grid_group grid = cg::this_grid();
    Fr F; F.a = &args; F.lds = lds; F.ws = args.ws; F.tid = threadIdx.x; F.lane = F.tid & 63; F.wave = __builtin_amdgcn_readfirstlane(F.tid >> 6); F.gw = blockIdx.x * NWAVES + F.wave;
    volatile LAS unsigned* bst = (volatile LAS unsigned*)((LAS unsigned char*)lds + 131072 + 1024);
    if (F.tid < 2) bst[F.tid] = 0u;
    __syncthreads();
    XcdBarrier bar = xcd_barrier_post((unsigned*)(args.ws + OFF_BAR), bst);
    const int cx_ = ((int)blockIdx.x & 7) * 32 + ((int)blockIdx.x >> 3), iw0 = cx_ >= 16 ? (cx_ - 16) * NWAVES + F.wave : -1, inw = 240 * NWAVES;
    PH(0) { phase_mod(F); conv_rwkv(F, 0, F.WTb(0)); phase_s5_params(F); } SEAM(0);
    RWKV_LAYER(1, 0, 0, args.in[0], args.in[2], 272, 0, (conv_mat(F, args.in[21], D, 4 * D, F.WTb(1), 0, iw0, inw), conv_mat(F, args.in[25], D, D, F.WTb(1), 4096, iw0, inw)))
    PH(8) { phase_norm_plain(F, 1); } SEAM(8);
    PH(9) { run_gemm(F, F.R(0), F.WTb(1), D, 1088, 0, 16, FNaIn{F.R(1), F.R(2), F.R(3), F.R(4)}); } SEAM(9);
    PH(11) { phase_na_attn(F); } SEAM(11);
    if (PROBE_MASK & 4) { phase_na_attn(F); xcd_barrier(bar); }
    PH(12) { run_gemm(F, F.R(5), F.WTb(1) + (size_t)4096 * D, D, 272, 0, 4, FResid{args.out, F.ctxbuf(), args.out, F.ctxbuf(), F.mod(1)});
             conv_mat(F, args.in[26], D, 2 * D, F.WTb(2), 0, iw0, inw); conv_mat(F, args.in[35], D, D, F.WTb(2), 2048, iw0, inw); conv_mat(F, args.in[37], D, D, F.WTb(2), 3072, iw0, inw); } SEAM(12);
    PH(13) { phase_norm_plain(F, 2); } SEAM(13);
    PH(14) { run_gemm(F, F.R(0), F.WTb(2), D, 544, 0, 8, FS5In{F.R(1), F.R(3)}); } SEAM(14);
    PH(15) { phase_s5_scan<false>(F); } SEAM(15);
    PH(16) { phase_s5_carry(F); } SEAM(16);
    PH(17) { phase_s5_scan<true>(F); } SEAM(17);
    if (PROBE_MASK & 2) { phase_s5_scan<false>(F); grid.sync(); phase_s5_carry(F); grid.sync(); phase_s5_scan<true>(F); xcd_barrier(bar); }
    PH(18) { phase_s5_combine(F); } SEAM(18);
    PH(19) { run_gemm(F, F.R(0), F.WTb(2) + (size_t)2048 * D, D, 272, 0, 4, FGlu{F.R(0), F.R(3), args.in[36], F.R(4)}); } SEAM(19);
    PH(20) { run_gemm(F, F.R(4), F.WTb(2) + (size_t)3072 * D, D, 272, 0, 4, FResid{args.out, F.ctxbuf(), args.out, F.ctxbuf(), F.mod(2)}); conv_rwkv(F, 1, F.WTb(3), iw0, inw); } SEAM(20);
    RWKV_LAYER(21, 3, 1, args.out, F.ctxbuf(), 256, 3, (void)0)
}

#ifndef MULTI_LAUNCH
#define MULTI_LAUNCH 0
#endif
extern "C" void kernel_launch(void* const* d_in, const int* in_sizes, int n_in, void* d_out, int out_size, void* d_ws, size_t ws_size, hipStream_t stream) {
    static int ready = 0;
    if (ready == 0) {
        ready = -1;
        if (n_in != 38 || ws_size < WS_NEED || out_size != NB * SEQ * D) { fprintf(stderr, "kernel_launch: unexpected problem (n_in %d ws %zu out %d)\n", n_in, ws_size, out_size); return; }
        if (hipFuncSetAttribute((const void*)fwd_kernel, hipFuncAttributeMaxDynamicSharedMemorySize, LDS_BYTES) != hipSuccess) { fprintf(stderr, "kernel_launch: hipFuncSetAttribute failed\n"); return; }
        int dev = 0, cus = 0, per_cu = 0;
        hipGetDevice(&dev); hipDeviceGetAttribute(&cus, hipDeviceAttributeMultiprocessorCount, dev);
        hipOccupancyMaxActiveBlocksPerMultiprocessor(&per_cu, (const void*)fwd_kernel, NTHR, LDS_BYTES);
        if (cus * per_cu < GRID) { fprintf(stderr, "kernel_launch: grid of %d not resident (%d CUs x %d)\n", GRID, cus, per_cu); return; }
        ready = 1;
    }
    if (ready < 0) return;
    if (hipMemsetAsync((char*)d_ws + OFF_BAR, 0, XCD_BAR_WORDS * 4, stream) != hipSuccess) { fprintf(stderr, "kernel_launch: memset failed\n"); return; }
    Args a{};
    for (int i = 0; i < 38; ++i) a.in[i] = (const float*)d_in[i];
    a.out = (float*)d_out; a.ws = (unsigned char*)d_ws;
#if MULTI_LAUNCH
    for (int ph = 0; ph < NPHASE; ++ph) { a.ph_lo = ph; a.ph_hi = ph + 1; hipLaunchKernelGGL(fwd_kernel, dim3(GRID), dim3(NTHR), LDS_BYTES, stream, a); }
#else
    a.ph_lo = 0; a.ph_hi = NPHASE;
    void* kargs[] = {&a};
    hipError_t e = hipLaunchCooperativeKernel((const void*)fwd_kernel, dim3(GRID), dim3(NTHR), kargs, LDS_BYTES, stream);
    if (e != hipSuccess) fprintf(stderr, "cooperative launch failed: %s\n", hipGetErrorString(e));
#endif
}
```
